# Optimizing an MI355X kernel written in HIP

```python
import jax, jax.numpy as jnp
from jax import lax
import numpy as np

D_MODEL = 1024
BATCH = 2
SEQ = 8192
DEPTH = 2
DEC_BATCH = 16
DEC_SEQ = 16
PAST_LEN = 4096

CHUNK = 64
MIX_WIDTH = D_MODEL
DN_WIDTH = MIX_WIDTH // 2
DN_HEADS = 4
DN_HEAD_DIM = DN_WIDTH // DN_HEADS
CONV_WIDTH = 4
CONV_CH = 3 * DN_WIDTH
POOL_WIDTH = MIX_WIDTH - DN_WIDTH
POOL_WINDOWS = (2, 4, 8, 16)
POOL_GROUPS = len(POOL_WINDOWS)
POOL_GROUP_DIM = POOL_WIDTH // POOL_GROUPS
POOL_HIST = max(POOL_WINDOWS) - 1
D_FF = 2816
N_IN = 4 * DN_WIDTH + 2 * DN_HEADS + POOL_WIDTH
EPS = 1e-6

kernel_name = "hybrid_deltanet_pool_macaron_step"


def rms_norm(x, w):
    x32 = x.astype(jnp.float32)
    y = x32 * lax.rsqrt(jnp.mean(x32 * x32, axis=-1, keepdims=True) + EPS)
    return (y * w.astype(jnp.float32)).astype(x.dtype)


def l2_norm(x):
    x32 = x.astype(jnp.float32)
    return x32 * lax.rsqrt(jnp.sum(x32 * x32, axis=-1, keepdims=True) + EPS)


def swiglu(x, w_gate, w_up, w_down):
    return (jax.nn.silu(x @ w_gate) * (x @ w_up)) @ w_down


def causal_dwconv(x, buf, w):
    L = x.shape[1]
    xpad = jnp.concatenate([buf.astype(x.dtype), x], axis=1)
    y = xpad[:, 0:L] * w[0]
    for j in range(1, CONV_WIDTH):
        y = y + xpad[:, j:j + L] * w[j]
    return y, xpad[:, -(CONV_WIDTH - 1):]


def gated_delta_rule(q, k, v, g, beta, s0, chunk):
    B, L, H, dk = q.shape
    dv = v.shape[-1]
    n = L // chunk
    f32 = jnp.float32

    def blocks(t):
        t = t.astype(f32).reshape((B, n, chunk) + t.shape[2:])
        return jnp.moveaxis(t, 2, 3)

    q, k, v, g, beta = blocks(q), blocks(k), blocks(v), blocks(g), blocks(beta)
    gc = jnp.cumsum(g, axis=-1)
    idx = jnp.arange(chunk)
    incl = idx[:, None] >= idx[None, :]
    strict = idx[:, None] > idx[None, :]
    decay = jnp.exp(jnp.where(incl, gc[..., :, None] - gc[..., None, :], -jnp.inf))
    kk = jnp.einsum('bnhid,bnhjd->bnhij', k, k)
    a_mat = jnp.where(strict, beta[..., :, None] * kk * decay, 0.0) + jnp.eye(chunk, dtype=f32)
    rhs = jnp.concatenate([v * beta[..., None], k * (beta * jnp.exp(gc))[..., None]], axis=-1)
    sol = lax.linalg.triangular_solve(a_mat, rhs, left_side=True, lower=True, unit_diagonal=True)
    u, w = sol[..., :dv], sol[..., dv:]
    qk = jnp.einsum('bnhid,bnhjd->bnhij', q, k) * decay
    g_last = gc[..., -1]
    q_dec = q * jnp.exp(gc)[..., None]
    k_dec = k * jnp.exp(g_last[..., None] - gc)[..., None]

    def step(S, xs):
        q_c, qk_c, u_c, w_c, k_c, gl = xs
        v_new = u_c - jnp.einsum('bhcd,bhde->bhce', w_c, S)
        o_c = jnp.einsum('bhcd,bhde->bhce', q_c, S) + jnp.einsum('bhij,bhje->bhie', qk_c, v_new)
        S = S * jnp.exp(gl)[..., None, None] + jnp.einsum('bhcd,bhce->bhde', k_c, v_new)
        return S, o_c

    xs = (jnp.moveaxis(q_dec, 1, 0), jnp.moveaxis(qk, 1, 0), jnp.moveaxis(u, 1, 0),
          jnp.moveaxis(w, 1, 0), jnp.moveaxis(k_dec, 1, 0), jnp.moveaxis(g_last, 1, 0))
    S, o = lax.scan(step, s0.astype(f32), xs)
    o = jnp.transpose(o, (1, 0, 3, 2, 4)).reshape(B, L, H, dv)
    return o, S


def multi_scale_pool(u, buf, w_pool, scale, pos0):
    B, L, _ = u.shape
    upad = jnp.concatenate([buf.astype(u.dtype), u], axis=1)
    cs = jnp.cumsum(upad.astype(jnp.float32), axis=1)
    cs = jnp.concatenate([jnp.zeros((B, 1, POOL_WIDTH), jnp.float32), cs], axis=1)
    pos = pos0 + jnp.arange(L)
    means = []
    for gi, win in enumerate(POOL_WINDOWS):
        sl = slice(gi * POOL_GROUP_DIM, (gi + 1) * POOL_GROUP_DIM)
        s = cs[:, POOL_HIST + 1:POOL_HIST + 1 + L, sl] - cs[:, POOL_HIST + 1 - win:POOL_HIST + 1 - win + L, sl]
        cnt = jnp.minimum(win, pos + 1).astype(jnp.float32)
        means.append(s / cnt[None, :, None])
    d = (jnp.concatenate(means, axis=-1) - u.astype(jnp.float32)).reshape(B, L, POOL_GROUPS, POOL_GROUP_DIM)
    z = jnp.einsum('blgc,gcd->blgd', d, w_pool.astype(jnp.float32)).reshape(B, L, POOL_WIDTH)
    z = z * scale.astype(jnp.float32)
    return z.astype(u.dtype), upad[:, -POOL_HIST:]


def mixer(h, w_in, conv_w, a_log, dt_bias, o_norm, w_pool, pool_scale, w_out,
          s0, conv_buf, pool_buf, pos0, chunk):
    B, L, _ = h.shape
    p = h @ w_in
    c1, c2, c3 = 3 * DN_WIDTH, 4 * DN_WIDTH, 4 * DN_WIDTH + DN_HEADS
    c4 = c3 + DN_HEADS
    qkv, gate, a, b, u = p[..., :c1], p[..., c1:c2], p[..., c2:c3], p[..., c3:c4], p[..., c4:]
    qkv, conv_new = causal_dwconv(qkv, conv_buf, conv_w)
    qkv = jax.nn.silu(qkv)
    q = qkv[..., :DN_WIDTH].reshape(B, L, DN_HEADS, DN_HEAD_DIM)
    k = qkv[..., DN_WIDTH:2 * DN_WIDTH].reshape(B, L, DN_HEADS, DN_HEAD_DIM)
    v = qkv[..., 2 * DN_WIDTH:].reshape(B, L, DN_HEADS, DN_HEAD_DIM)
    q = l2_norm(q) * (DN_HEAD_DIM ** -0.5)
    k = l2_norm(k)
    beta = jax.nn.sigmoid(b.astype(jnp.float32))
    g = -jnp.exp(a_log.astype(jnp.float32)) * jax.nn.softplus(a.astype(jnp.float32) + dt_bias.astype(jnp.float32))
    o, s_new = gated_delta_rule(q, k, v, g, beta, s0, chunk)
    o = rms_norm(o.astype(h.dtype), o_norm) * jax.nn.silu(gate.reshape(B, L, DN_HEADS, DN_HEAD_DIM))
    o = o.reshape(B, L, DN_WIDTH)
    z, pool_new = multi_scale_pool(u, pool_buf, w_pool, pool_scale, pos0)
    out = jnp.concatenate([o, z.astype(o.dtype)], axis=-1) @ w_out
    return out, s_new.astype(s0.dtype), conv_new, pool_new


def setup_inputs(seed: int = 0) -> dict:
    key = jax.random.key(seed)
    ks = jax.random.split(key, 24)
    f32 = jnp.float32
    nrm = lambda k, shape, s: jax.random.normal(k, shape, f32) * s
    dt = jnp.exp(jax.random.uniform(ks[10], (DEPTH, DN_HEADS), f32, np.log(1e-3), np.log(1e-1)))
    return {
        "x_prompt": nrm(ks[0], (BATCH, SEQ, D_MODEL), 1.0),
        "x_sample": nrm(ks[1], (DEC_BATCH, DEC_SEQ, D_MODEL), 1.0),
        "state_delta": nrm(ks[2], (DEPTH, DEC_BATCH, DN_HEADS, DN_HEAD_DIM, DN_HEAD_DIM), 0.05),
        "state_conv": nrm(ks[3], (DEPTH, DEC_BATCH, CONV_WIDTH - 1, CONV_CH), 1.0),
        "state_pool": nrm(ks[4], (DEPTH, DEC_BATCH, POOL_HIST, POOL_WIDTH), 1.0),
        "norm_ffn1": 1.0 + nrm(ks[5], (DEPTH, D_MODEL), 0.02),
        "w_ffn1_gate": nrm(ks[6], (DEPTH, D_MODEL, D_FF), D_MODEL ** -0.5),
        "w_ffn1_up": nrm(ks[7], (DEPTH, D_MODEL, D_FF), D_MODEL ** -0.5),
        "w_ffn1_down": nrm(ks[8], (DEPTH, D_FF, D_MODEL), D_FF ** -0.5),
        "norm_mix": 1.0 + nrm(ks[9], (DEPTH, D_MODEL), 0.02),
        "w_in": nrm(ks[11], (DEPTH, D_MODEL, N_IN), D_MODEL ** -0.5),
        "conv_w": nrm(ks[12], (DEPTH, CONV_WIDTH, CONV_CH), CONV_WIDTH ** -0.5),
        "a_log": jnp.log(jax.random.uniform(ks[13], (DEPTH, DN_HEADS), f32, 1.0, 16.0)),
        "dt_bias": dt + jnp.log(-jnp.expm1(-dt)),
        "o_norm": 1.0 + nrm(ks[14], (DEPTH, DN_HEAD_DIM), 0.02),
        "w_pool": nrm(ks[15], (DEPTH, POOL_GROUPS, POOL_GROUP_DIM, POOL_GROUP_DIM), POOL_GROUP_DIM ** -0.5),
        "pool_scale": 1.0 + nrm(ks[16], (DEPTH, POOL_WIDTH), 0.02),
        "w_out": nrm(ks[17], (DEPTH, MIX_WIDTH, D_MODEL), MIX_WIDTH ** -0.5),
        "norm_ffn2": 1.0 + nrm(ks[18], (DEPTH, D_MODEL), 0.02),
        "w_ffn2_gate": nrm(ks[19], (DEPTH, D_MODEL, D_FF), D_MODEL ** -0.5),
        "w_ffn2_up": nrm(ks[20], (DEPTH, D_MODEL, D_FF), D_MODEL ** -0.5),
        "w_ffn2_down": nrm(ks[21], (DEPTH, D_FF, D_MODEL), D_FF ** -0.5),
        "norm_final": 1.0 + nrm(ks[22], (D_MODEL,), 0.02),
    }


def reference(x_prompt, x_sample, state_delta, state_conv, state_pool,
              norm_ffn1, w_ffn1_gate, w_ffn1_up, w_ffn1_down, norm_mix, w_in, conv_w,
              a_log, dt_bias, o_norm, w_pool, pool_scale, w_out,
              norm_ffn2, w_ffn2_gate, w_ffn2_up, w_ffn2_down, norm_final):
    dt = x_prompt.dtype

    def layer(x, l, s0, conv_buf, pool_buf, pos0, chunk):
        x = x + 0.5 * swiglu(rms_norm(x, norm_ffn1[l]), w_ffn1_gate[l], w_ffn1_up[l], w_ffn1_down[l])
        m, s_new, conv_new, pool_new = mixer(rms_norm(x, norm_mix[l]), w_in[l], conv_w[l], a_log[l],
                                             dt_bias[l], o_norm[l], w_pool[l], pool_scale[l], w_out[l],
                                             s0, conv_buf, pool_buf, pos0, chunk)
        x = x + m
        x = x + 0.5 * swiglu(rms_norm(x, norm_ffn2[l]), w_ffn2_gate[l], w_ffn2_up[l], w_ffn2_down[l])
        return x, s_new, conv_new, pool_new

    xp = x_prompt
    p_delta, p_conv, p_pool = [], [], []
    for l in range(DEPTH):
        xp, s_new, c_new, q_new = layer(
            xp, l,
            jnp.zeros((BATCH, DN_HEADS, DN_HEAD_DIM, DN_HEAD_DIM), dt),
            jnp.zeros((BATCH, CONV_WIDTH - 1, CONV_CH), dt),
            jnp.zeros((BATCH, POOL_HIST, POOL_WIDTH), dt),
            0, CHUNK)
        p_delta.append(s_new); p_conv.append(c_new); p_pool.append(q_new)
    y_prompt = rms_norm(xp, norm_final)

    xs = x_sample
    s_delta, s_conv, s_pool = [], [], []
    for l in range(DEPTH):
        xs, s_new, c_new, q_new = layer(xs, l, state_delta[l], state_conv[l], state_pool[l],
                                        PAST_LEN, xs.shape[1])
        s_delta.append(s_new); s_conv.append(c_new); s_pool.append(q_new)
    y_sample = rms_norm(xs, norm_final)

    return (y_prompt, y_sample,
            jnp.stack(p_delta), jnp.stack(p_conv), jnp.stack(p_pool),
            jnp.stack(s_delta), jnp.stack(s_conv), jnp.stack(s_pool))
```

```cpp
#include <hip/hip_runtime.h>
#include <hip/hip_cooperative_groups.h>
namespace cg = cooperative_groups;
namespace pg8 {
#define PG8_LAS __attribute__((address_space(3)))
typedef unsigned short bf16_t;
typedef short bf16x8 __attribute__((ext_vector_type(8)));
typedef float f32x4 __attribute__((ext_vector_type(4)));
typedef unsigned u32x4 __attribute__((ext_vector_type(4)));
constexpr int BM = 256, BK = 64, HALF = 128, HTB = HALF * BK * 2  , STAGE_BYTES = 8 * HTB, NXCD = 8, WGM = 8;

__host__ __device__ __forceinline__ int lds_byte(int r, int c) { const int st = (r >> 4) * 2 + (c >> 5), rr = r & 15, cc = c & 31, ob = rr * 64 + cc * 2; return st * 1024 + (ob ^ (((ob >> 9) & 1) << 5)); }
__host__ __device__ __forceinline__ void stage_rc(int b, int& R, int& C) { const int st = b / 1024, sb = b % 1024, swz = sb ^ (((sb >> 9) & 1) << 5); R = (st >> 1) * 16 + swz / 64; C = (st & 1) * 32 + (swz % 64) / 2; }
__host__ __device__ __forceinline__ int perm32(int rho) { const int n = rho >> 4, i = rho & 15; return 8 * (i >> 2) + 4 * n + (i & 3); }

struct Unit { int pm, pn; };
struct Gemm { const bf16_t* A; const bf16_t* Bt; int M, N, K, ld; };

struct StaticOrder {
    int nM, nN, nwg, G, c;
    __host__ __device__ void init(int M, int N, int G_, int c_) { nM = M / BM; nN = N / BM; nwg = nM * nN; G = G_; c = c_; }
    __host__ __device__ bool next(int i, Unit& u) const {
        const long L = (long)i * G + c; if (L >= nwg) return false;
        int wgid = (int)L; { const int q = nwg / NXCD, r = nwg % NXCD, xcd = wgid % NXCD, off = wgid / NXCD; wgid = (xcd < r ? xcd * (q + 1) : r * (q + 1) + (xcd - r) * q) + off; }
        const int nig = WGM * nN, gid = wgid / nig, fm = gid * WGM, gsz = (nM - fm) < WGM ? (nM - fm) : WGM;
        u.pm = fm + ((wgid % nig) % gsz); u.pn = (wgid % nig) / gsz; return true;
    }
    __device__ __forceinline__ void a_ready(const Unit&) const {}
    __device__ __forceinline__ void done(const Unit&) const {}
};
__device__ __forceinline__ unsigned cvt_pk_bf16(float lo, float hi) { unsigned r; asm volatile("v_cvt_pk_bf16_f32 %0, %1, %2" : "=v"(r) : "v"(lo), "v"(hi)); return r; }
template <class Epi, class Sched, bool ALIGN_EPI = false, bool SP2 = false>
__device__ __forceinline__ void gemm_phase(PG8_LAS unsigned char* lds, const Gemm g, const Sched& S, const Epi& E, int tid0) {
    const int tid = tid0, wid = __builtin_amdgcn_readfirstlane(tid >> 6), lane = tid & 63, wr = wid >> 2, wc = wid & 3, fr = lane & 15, fq = lane >> 4;
    const int K = g.K, nt = K / BK;
    unsigned voffA[2], voffB[2];
#pragma unroll
    for (int i = 0; i < 2; ++i) { int R, C; stage_rc(tid * 16 + i * 8192, R, C); const int Rb = Epi::PERM ? ((R & ~31) + perm32(R & 31)) : R;
        voffA[i] = (unsigned)(R * g.ld + C) * 2u; voffB[i] = (unsigned)(Rb * g.ld + C) * 2u; }
    const size_t kstep = (size_t)(BK * 2);
    const size_t hstep = (size_t)HALF * g.ld * 2;
    const size_t tstep = 2 * hstep;
    const unsigned ldsw = (unsigned)wid * 1024u;
    const int aoff = lds_byte(wr * 64 + fr, fq * 8), boff = lds_byte(wc * 32 + fr, fq * 8);
#define PG8_SA(b, h) (((b) * 2 + (h)) * HTB)
#define PG8_SB(b, h) ((4 + (b) * 2 + (h)) * HTB)
#define PG8_STAGE(bufoff, gbase, voff) do { _Pragma("unroll") for (int _i = 0; _i < 2; ++_i) \
        __builtin_amdgcn_global_load_lds((const unsigned*)((const char*)(gbase) + (voff)[_i]), (PG8_LAS unsigned*)(lds + (bufoff) + ldsw + _i * 8192), 16, 0, 0); } while (0)
#define PG8_LDA(dst, b, h) do { _Pragma("unroll") for (int m = 0; m < 4; ++m) _Pragma("unroll") for (int k = 0; k < 2; ++k) dst[m][k] = *(const PG8_LAS bf16x8*)(lds + PG8_SA(b, h) + aoff + m * 2048 + k * 1024); } while (0)
#define PG8_LDB(dst, b, h) do { _Pragma("unroll") for (int n = 0; n < 2; ++n) _Pragma("unroll") for (int k = 0; k < 2; ++k) dst[n][k] = *(const PG8_LAS bf16x8*)(lds + PG8_SB(b, h) + boff + n * 2048 + k * 1024); } while (0)
#define PG8_MMA(ai, bj, At, Bt) do { __builtin_amdgcn_s_setprio(1); _Pragma("unroll") for (int m = 0; m < 4; ++m) _Pragma("unroll") for (int n = 0; n < 2; ++n) _Pragma("unroll") for (int k = 0; k < 2; ++k) \
        acc[ai][bj][m][n] = __builtin_amdgcn_mfma_f32_16x16x32_bf16(Bt[n][k], At[m][k], acc[ai][bj][m][n], 0, 0, 0); __builtin_amdgcn_s_setprio(0); } while (0)
#define PG8_WAIT_V(n) asm volatile("s_waitcnt vmcnt(" #n ")" ::: "memory")
#define PG8_WAIT_L(n) asm volatile("s_waitcnt lgkmcnt(" #n ")" ::: "memory")
#define PG8_BAR __builtin_amdgcn_s_barrier()
#define PG8_SCHED __builtin_amdgcn_sched_barrier(0)
    Unit cur, nxt; int ui = 0;
    if (!S.next(0, cur)) return;
    f32x4 acc[2][2][4][2];
#pragma unroll
    for (int a = 0; a < 2; ++a)
#pragma unroll
        for (int b = 0; b < 2; ++b)
#pragma unroll
            for (int m = 0; m < 4; ++m)
#pragma unroll
                for (int n = 0; n < 2; ++n) acc[a][b][m][n] = (f32x4){0.f, 0.f, 0.f, 0.f};
    bf16x8 At[4][2], B0[2][2], B1[2][2];
    const char* cA = (const char*)g.A + (size_t)cur.pm * tstep; const char* cB = (const char*)g.Bt + (size_t)cur.pn * tstep;
    S.a_ready(cur);
    if constexpr (SP2) {
        PG8_STAGE(PG8_SB(0, 0), cB, voffB); PG8_STAGE(PG8_SB(0, 1), cB + hstep, voffB); PG8_STAGE(PG8_SA(0, 0), cA, voffA); PG8_STAGE(PG8_SA(0, 1), cA + hstep, voffA);
        if (wr == 1) PG8_BAR;
        PG8_WAIT_V(2); PG8_BAR;
        PG8_STAGE(PG8_SB(1, 0), cB + kstep, voffB); PG8_STAGE(PG8_SA(1, 0), cA + kstep, voffA); PG8_STAGE(PG8_SB(1, 1), cB + hstep + kstep, voffB);
        PG8_WAIT_V(6); PG8_BAR;
    } else {
        PG8_STAGE(PG8_SB(0, 0), cB, voffB); PG8_STAGE(PG8_SA(0, 0), cA, voffA); PG8_STAGE(PG8_SB(0, 1), cB + hstep, voffB); PG8_STAGE(PG8_SA(0, 1), cA + hstep, voffA);
        if (wr == 1) PG8_BAR;
        PG8_WAIT_V(4); PG8_BAR;
        PG8_STAGE(PG8_SB(1, 0), cB + kstep, voffB); PG8_STAGE(PG8_SA(1, 0), cA + kstep, voffA); PG8_STAGE(PG8_SB(1, 1), cB + hstep + kstep, voffB);
        PG8_WAIT_V(6); PG8_BAR;
    }
    for (;;) {
        const bool has_next = S.next(ui + 1, nxt);
        const char* nA = has_next ? (const char*)g.A + (size_t)nxt.pm * tstep : cA; const char* nB = has_next ? (const char*)g.Bt + (size_t)nxt.pn * tstep : cB;
        for (int t = 0; t < nt; t += 2) {
            const bool last = (t == nt - 2);
            const char* a1 = cA + (size_t)(t + 1) * kstep;
            const char* a2 = last ? nA : cA + (size_t)(t + 2) * kstep; const char* b2 = last ? nB : cB + (size_t)(t + 2) * kstep;
            const char* a3 = a2 + kstep; const char* b3 = b2 + kstep;
            if (last && has_next) S.a_ready(nxt);
            if constexpr (SP2) {
            PG8_LDB(B0, 0, 0); PG8_LDB(B1, 0, 1); PG8_SCHED; PG8_LDA(At, 0, 0); PG8_STAGE(PG8_SA(1, 1), a1 + hstep, voffA);
            PG8_WAIT_V(8); PG8_WAIT_L(0); PG8_BAR; PG8_MMA(0, 0, At, B0); PG8_MMA(0, 1, At, B1); PG8_BAR; PG8_SCHED;
            PG8_LDA(At, 0, 1); PG8_STAGE(PG8_SB(0, 0), b2, voffB); PG8_STAGE(PG8_SB(0, 1), b2 + hstep, voffB); PG8_STAGE(PG8_SA(0, 0), a2, voffA);
            PG8_WAIT_V(8); PG8_WAIT_L(0); PG8_BAR; PG8_MMA(1, 0, At, B0); PG8_MMA(1, 1, At, B1); PG8_BAR; PG8_SCHED;
            PG8_LDB(B0, 1, 0); PG8_LDB(B1, 1, 1); PG8_SCHED; PG8_LDA(At, 1, 0); PG8_STAGE(PG8_SA(0, 1), a2 + hstep, voffA);
            PG8_WAIT_V(8); PG8_WAIT_L(0); PG8_BAR; PG8_MMA(0, 0, At, B0); PG8_MMA(0, 1, At, B1); PG8_BAR; PG8_SCHED;
            PG8_LDA(At, 1, 1); PG8_STAGE(PG8_SB(1, 0), b3, voffB); PG8_STAGE(PG8_SB(1, 1), b3 + hstep, voffB); PG8_STAGE(PG8_SA(1, 0), a3, voffA);
            PG8_WAIT_V(8); PG8_WAIT_L(0); PG8_BAR; PG8_MMA(1, 0, At, B0); PG8_MMA(1, 1, At, B1); PG8_BAR; PG8_SCHED;
            } else {
            PG8_LDB(B0, 0, 0); PG8_SCHED; PG8_LDA(At, 0, 0); PG8_STAGE(PG8_SA(1, 1), a1 + hstep, voffA);
            PG8_WAIT_L(8); PG8_BAR; PG8_WAIT_L(0); PG8_MMA(0, 0, At, B0); PG8_BAR; PG8_SCHED;
            PG8_LDB(B1, 0, 1); PG8_STAGE(PG8_SB(0, 0), b2, voffB);
            PG8_BAR; PG8_WAIT_L(0); PG8_MMA(0, 1, At, B1); PG8_BAR;
            PG8_LDA(At, 0, 1); PG8_STAGE(PG8_SA(0, 0), a2, voffA);
            PG8_BAR; PG8_WAIT_L(0); PG8_MMA(1, 0, At, B0); PG8_BAR; PG8_SCHED;
            PG8_STAGE(PG8_SB(0, 1), b2 + hstep, voffB);
            PG8_WAIT_V(6); PG8_BAR; PG8_MMA(1, 1, At, B1); PG8_BAR;
            PG8_LDB(B0, 1, 0); PG8_SCHED; PG8_LDA(At, 1, 0); PG8_STAGE(PG8_SA(0, 1), a2 + hstep, voffA);
            PG8_WAIT_L(8); PG8_BAR; PG8_WAIT_L(0); PG8_MMA(0, 0, At, B0); PG8_BAR; PG8_SCHED;
            PG8_LDB(B1, 1, 1); PG8_STAGE(PG8_SB(1, 0), b3, voffB);
            PG8_BAR; PG8_WAIT_L(0); PG8_MMA(0, 1, At, B1); PG8_BAR;
            PG8_LDA(At, 1, 1); PG8_STAGE(PG8_SA(1, 0), a3, voffA);
            PG8_BAR; PG8_WAIT_L(0); PG8_MMA(1, 0, At, B0); PG8_BAR; PG8_SCHED;
            PG8_STAGE(PG8_SB(1, 1), b3 + hstep, voffB);
            PG8_WAIT_V(6); PG8_BAR; PG8_MMA(1, 1, At, B1); PG8_BAR;
            }
        }
        if constexpr (ALIGN_EPI) { if (wr == 0) PG8_BAR; }
        if constexpr (!Epi::AFTER_DRAIN) { E(acc, cur, wr, wc, fr, fq); S.done(cur); }
        if (!has_next) break;
#pragma unroll
        for (int a = 0; a < 2; ++a)
#pragma unroll
            for (int b = 0; b < 2; ++b)
#pragma unroll
                for (int m = 0; m < 4; ++m)
#pragma unroll
                    for (int n = 0; n < 2; ++n) acc[a][b][m][n] = (f32x4){0.f, 0.f, 0.f, 0.f};
        cur = nxt; cA = nA; cB = nB; ++ui;
        if constexpr (ALIGN_EPI) { if (wr == 1) PG8_BAR; }
    }
    PG8_WAIT_V(0);
    if constexpr (!ALIGN_EPI) { if (wr == 0) PG8_BAR; }
    PG8_BAR;
    if constexpr (Epi::AFTER_DRAIN) { E.fused(acc, cur, wr, wc, fr, fq, lds, wid, lane); S.done(cur); }
#undef PG8_SA
#undef PG8_SB
#undef PG8_STAGE
#undef PG8_LDA
#undef PG8_LDB
#undef PG8_MMA
#undef PG8_WAIT_V
#undef PG8_WAIT_L
#undef PG8_BAR
#undef PG8_SCHED
}
}

#define LAS __attribute__((address_space(3)))
using pg8::bf16_t; using pg8::bf16x8; using pg8::f32x4; using pg8::u32x4;
typedef unsigned u32x2 __attribute__((ext_vector_type(2)));

constexpr int D = 1024, FF = 2816, NUP = 5632, NINP = 2816, PW = 2560;
constexpr int MP = 16384, M = 16640, SEQ = 8192;
constexpr int NTASK = 1088, NPTASK = 1088;
constexpr float EPS = 1e-6f;
constexpr int NPH = 20;
#ifndef PHM
#define PHM 255
#endif
#ifndef PROBE_REP
#define PROBE_REP 0
#endif
#ifndef PROBE_SYNCS
#define PROBE_SYNCS 0
#endif
constexpr int LDS_BYTES = 148480;
constexpr int LDS_BARW = 147968;

constexpr size_t WS_AREG = 0;
constexpr size_t WS_XB   = 93716480;
constexpr size_t WS_MIX  = 127795200;
constexpr size_t WS_D1   = 161873920;
constexpr size_t WS_WX   = 233177088;
constexpr size_t WS_ROWSS= 256245760;
constexpr size_t WS_AB   = 263700480;
constexpr size_t WS_GL   = 264232960;
constexpr size_t WS_WPT  = 264237312;
constexpr size_t WS_BAR  = 264499456;
constexpr size_t WS_RSTD = 264513280;
constexpr size_t WX_UP = 0, WX_DOWN = 11534336, WX_WIN = 17301504;
constexpr size_t DO_SNT = 0;
constexpr size_t DO_QK  = 35651584;
constexpr size_t DO_WY  = 44564480;
constexpr size_t WY_OUT = 0, WY_UP = 2097152, WY_DOWN = 13631488;
constexpr size_t O_PD = 17039360, O_PC = 17301504, O_PP = 17319936, O_SD = 17350656, O_SC = 19447808, O_SP = 19595264;

struct Params { const float* in[23]; float* out; unsigned char* ws; int ph_lo, ph_hi; };

__device__ __forceinline__ float bf2f(bf16_t v) { return __uint_as_float(((unsigned)v) << 16); }
__device__ __forceinline__ float bflo(unsigned u) { return __uint_as_float(u << 16); }
__device__ __forceinline__ float bfhi(unsigned u) { return __uint_as_float(u & 0xffff0000u); }
__device__ __forceinline__ unsigned pk2(float lo, float hi) {
    typedef float f2 __attribute__((ext_vector_type(2))); typedef __bf16 b2 __attribute__((ext_vector_type(2)));
    f2 v = {lo, hi}; b2 b = __builtin_convertvector(v, b2); return __builtin_bit_cast(unsigned, b);
}
__device__ __forceinline__ bf16_t f2bf(float x) { return (bf16_t)(pk2(x, 0.f) & 0xffffu); }
__device__ __forceinline__ float row_rstd(const float* part, int r) {
    const f32x4* q = (const f32x4*)(part + (size_t)r * 16);
    const f32x4 a = q[0], b = q[1], c = q[2], d = q[3];
    const float s = ((a.x + a.y) + (a.z + a.w)) + ((b.x + b.y) + (b.z + b.w)) + ((c.x + c.y) + (c.z + c.w)) + ((d.x + d.y) + (d.z + d.w));
    return rsqrtf(s * (1.f / 1024.f) + 1e-6f);
}
__device__ __forceinline__ float silu_f(float x) { return x * __builtin_amdgcn_rcpf(1.f + __expf(-x)); }
__device__ __forceinline__ float wave_sum(float v) {
#pragma unroll
    for (int o = 1; o < 64; o <<= 1) v += __shfl_xor(v, o);
    return v;
}
__device__ __forceinline__ float red16(float v) {
    v += __builtin_bit_cast(float, __builtin_amdgcn_update_dpp(0, __builtin_bit_cast(int, v), 0xB1, 0xF, 0xF, true));
    v += __builtin_bit_cast(float, __builtin_amdgcn_update_dpp(0, __builtin_bit_cast(int, v), 0x4E, 0xF, 0xF, true));
    v += __builtin_bit_cast(float, __builtin_amdgcn_update_dpp(0, __builtin_bit_cast(int, v), 0x141, 0xF, 0xF, true));
    v += __builtin_bit_cast(float, __builtin_amdgcn_update_dpp(0, __builtin_bit_cast(int, v), 0x140, 0xF, 0xF, true));
    return v;
}
#define LDS_WAIT() asm volatile("s_waitcnt lgkmcnt(0)" ::: "memory")
#define MFMA16(a, b, c) __builtin_amdgcn_mfma_f32_16x16x32_bf16((a), (b), (c), 0, 0, 0)


#define XB_TMO      128
#define XB_XCNT(j)  (256  + 64 * (j))
#define XB_XSUB(j)  (1280 + 64 * (j))
#define XB_XGEN(j)  (2304 + 64 * (j))
#define XB_TOP      3328
#define XB_TOPGEN   3392
#define XCD_BAR_WORDS 3456
#define XB_SPIN_CAP (1u << 20)
__device__ __forceinline__ unsigned xb_ld(unsigned* p)              { return __hip_atomic_load(p, __ATOMIC_RELAXED, __HIP_MEMORY_SCOPE_AGENT); }
__device__ __forceinline__ unsigned xb_add(unsigned* p, unsigned v) { return __hip_atomic_fetch_add(p, v, __ATOMIC_RELAXED, __HIP_MEMORY_SCOPE_AGENT); }
__device__ __forceinline__ unsigned xb_xcc_id() { return (unsigned)__builtin_amdgcn_s_getreg((3 << 11) | 20) & 0xFu; }
#define XB_SPIN(cond, bar) do { unsigned _sp = 0; while (cond) { __builtin_amdgcn_s_sleep(1); \
    if ((++_sp & 255u) == 0u) { if (xb_ld(&(bar)[XB_TMO])) break; if (_sp > XB_SPIN_CAP) { atomicAdd(&(bar)[XB_TMO], 1u); break; } } } } while (0)
struct XcdBarrier { unsigned* bar; unsigned x; volatile LAS unsigned* st; };
__device__ __forceinline__ XcdBarrier xcd_barrier_post(unsigned* bar, volatile LAS unsigned* st) {
    XcdBarrier b; b.bar = bar; b.x = xb_xcc_id(); b.st = st;
    if (threadIdx.x == 0) (void)xb_add(&bar[XB_XCNT(b.x)], 1u);
    return b;
}
__device__ __forceinline__ void xcd_barrier_complete(unsigned* bar, unsigned x, unsigned& nloc, unsigned& nx) {
    const unsigned G = gridDim.x * gridDim.y * gridDim.z;
    unsigned sum, cnt, mine, sp = 0u;
    for (;;) {
        sum = 0u; cnt = 0u; mine = 0u;
#pragma unroll
        for (unsigned j = 0; j < 16; ++j) { const unsigned c = xb_ld(&bar[XB_XCNT(j)]); sum += c; cnt += (c > 0u) ? 1u : 0u; mine = (j == x) ? c : mine; }
        if (sum == G) break;
        __builtin_amdgcn_s_sleep(1);
        if ((++sp & 255u) == 0u) { if (xb_ld(&bar[XB_TMO])) break; if (sp > XB_SPIN_CAP) { atomicAdd(&bar[XB_TMO], 1u); break; } }
    }
    nloc = mine > 0u ? mine : 1u; nx = cnt > 0u ? cnt : 1u;
}
__device__ __forceinline__ void xcd_barrier(const XcdBarrier& b) {
    asm volatile("s_waitcnt vmcnt(0)" ::: "memory");
    __syncthreads();
    if (threadIdx.x == 0) {
        unsigned* bar = b.bar;
        __builtin_amdgcn_s_waitcnt(0);
        unsigned nloc = b.st[0], nx = b.st[1];
        if (nloc == 0u) { xcd_barrier_complete(bar, b.x, nloc, nx); b.st[0] = nloc; b.st[1] = nx; }
        const unsigned old = xb_add(&bar[XB_XSUB(b.x)], 1u);
        const unsigned gen = old / nloc;
        if (old + 1u == (gen + 1u) * nloc) {
            __builtin_amdgcn_fence(__ATOMIC_RELEASE, "agent");
            asm volatile("s_waitcnt vmcnt(0)" ::: "memory");
            const unsigned og = xb_add(&bar[XB_TOP], 1u);
            const unsigned tg = og / nx;
            if (og + 1u == (tg + 1u) * nx) xb_add(&bar[XB_TOPGEN], 1u);
            else XB_SPIN(xb_ld(&bar[XB_TOPGEN]) == tg, bar);
            __builtin_amdgcn_fence(__ATOMIC_ACQUIRE, "agent");
            xb_add(&bar[XB_XGEN(b.x)], 1u);
            asm volatile("s_waitcnt vmcnt(0)" ::: "memory");
        } else {
            XB_SPIN(xb_ld(&bar[XB_XGEN(b.x)]) == gen, bar);
            __builtin_amdgcn_fence(__ATOMIC_ACQUIRE, "agent");
            asm volatile("s_waitcnt vmcnt(0)" ::: "memory");
        }
    }
    __syncthreads();
}

struct EpiUp {
    static constexpr bool PERM = true, AFTER_DRAIN = false;
    bf16_t* act; const float* rstd;
    __device__ __forceinline__ void operator()(const f32x4 (&acc)[2][2][4][2], const pg8::Unit& u, int wr, int wc, int fr, int fq) const {
        const int row0 = u.pm * 256 + wr * 64 + fr, col0 = u.pn * 128 + wc * 32 + 8 * fq;
        float rs8[8];
#pragma unroll
        for (int q = 0; q < 8; ++q) rs8[q] = this->rstd[row0 + (q >> 2) * 128 + (q & 3) * 16];
#pragma unroll
        for (int ai = 0; ai < 2; ++ai)
#pragma unroll
            for (int m = 0; m < 4; ++m) {
                const int r = row0 + ai * 128 + m * 16;
                const float rstd = rs8[ai * 4 + m];
                float o[8];
#pragma unroll
                for (int n = 0; n < 2; ++n) {
                    const f32x4 ga = acc[ai][0][m][n], ua = acc[ai][1][m][n];
                    const f32x4 e4 = ga * (rstd * -1.4426950408889634f);
                    const f32x4 gu = ga * ua * (rstd * rstd);
#pragma unroll
                    for (int j = 0; j < 4; ++j) o[n * 4 + j] = gu[j] * __builtin_amdgcn_rcpf(1.f + __builtin_amdgcn_exp2f(e4[j]));
                }
                u32x4 w; w.x = pk2(o[0], o[1]); w.y = pk2(o[2], o[3]); w.z = pk2(o[4], o[5]); w.w = pk2(o[6], o[7]);
                *(u32x4*)(act + (size_t)r * FF + col0) = w;
            }
    }
};
struct EpiRes {
    static constexpr bool PERM = true, AFTER_DRAIN = false;
    bf16_t* xb; float* xf; float* rowss_out; float scale; int f32out;
    __device__ __forceinline__ void operator()(const f32x4 (&acc)[2][2][4][2], const pg8::Unit& u, int wr, int wc, int fr, int fq) const {
        const int row0 = u.pm * 256 + wr * 64 + fr, col0 = u.pn * 256 + wc * 32 + 8 * fq;
#pragma unroll
        for (int ai = 0; ai < 2; ++ai) {
        u32x4 xv[2][4][2];
#pragma unroll
            for (int m = 0; m < 4; ++m)
#pragma unroll
                for (int bj = 0; bj < 2; ++bj) xv[ai][m][bj] = *(const u32x4*)(xb + (size_t)(row0 + ai * 128 + m * 16) * D + col0 + bj * 128);
#pragma unroll
            for (int m = 0; m < 4; ++m) {
                const int r = row0 + ai * 128 + m * 16;
                float ss = 0.f;
#pragma unroll
                for (int bj = 0; bj < 2; ++bj) {
                    bf16_t* xp = xb + (size_t)r * D + col0 + bj * 128;
                    const u32x4 q = xv[ai][m][bj];
                    float v[8];
                    v[0] = bflo(q.x); v[1] = bfhi(q.x); v[2] = bflo(q.y); v[3] = bfhi(q.y); v[4] = bflo(q.z); v[5] = bfhi(q.z); v[6] = bflo(q.w); v[7] = bfhi(q.w);
#pragma unroll
                    for (int n = 0; n < 2; ++n)
#pragma unroll
                        for (int j = 0; j < 4; ++j) { v[n * 4 + j] += scale * acc[ai][bj][m][n][j]; ss += v[n * 4 + j] * v[n * 4 + j]; }
                    if (f32out) {
                        float* fp = xf + (size_t)r * D + col0 + bj * 128;
                        *(f32x4*)fp = (f32x4){v[0], v[1], v[2], v[3]}; *(f32x4*)(fp + 4) = (f32x4){v[4], v[5], v[6], v[7]};
                    } else {
                        u32x4 w; w.x = pk2(v[0], v[1]); w.y = pk2(v[2], v[3]); w.z = pk2(v[4], v[5]); w.w = pk2(v[6], v[7]);
                        *(u32x4*)xp = w;
                    }
                }
                ss += __shfl_xor(ss, 16); ss += __shfl_xor(ss, 32);
                if (fq == 0) rowss_out[(size_t)r * 16 + u.pn * 4 + wc] = ss;
            }
        }
    }
};
struct SingleOrder {
    int pn; bool have;
    __device__ bool next(int i, pg8::Unit& u) const { if (i != 0 || !have) return false; u.pm = 0; u.pn = pn; return true; }
    __device__ __forceinline__ void a_ready(const pg8::Unit&) const {}
    __device__ __forceinline__ void done(const pg8::Unit&) const {}
};
struct EpiPart {
    static constexpr bool PERM = true, AFTER_DRAIN = false;
    float* part;
    __device__ __forceinline__ void operator()(const f32x4 (&acc)[2][2][4][2], const pg8::Unit& u, int wr, int wc, int fr, int fq) const {
        const int row0 = wr * 64 + fr, col0 = u.pn * 256 + wc * 32 + 8 * fq;
#pragma unroll
        for (int ai = 0; ai < 2; ++ai)
#pragma unroll
            for (int m = 0; m < 4; ++m)
#pragma unroll
                for (int bj = 0; bj < 2; ++bj) {
                    float* fp = part + (size_t)(row0 + ai * 128 + m * 16) * D + col0 + bj * 128;
                    *(f32x4*)fp = acc[ai][bj][m][0]; *(f32x4*)(fp + 4) = acc[ai][bj][m][1];
                }
    }
};
struct EpiIn {
    static constexpr bool PERM = true, AFTER_DRAIN = false;
    bf16_t* p; float* ab; const float* rstd;
    __device__ __forceinline__ void operator()(const f32x4 (&acc)[2][2][4][2], const pg8::Unit& u, int wr, int wc, int fr, int fq) const {
        const int row0 = u.pm * 256 + wr * 64 + fr, col0 = u.pn * 256 + wc * 32 + 8 * fq;
        float rs8[8];
#pragma unroll
        for (int q = 0; q < 8; ++q) rs8[q] = this->rstd[row0 + (q >> 2) * 128 + (q & 3) * 16];
#pragma unroll
        for (int ai = 0; ai < 2; ++ai)
#pragma unroll
            for (int m = 0; m < 4; ++m) {
                const int r = row0 + ai * 128 + m * 16;
                const float rstd = rs8[ai * 4 + m];
                if (u.pn < 10) {
#pragma unroll
                    for (int bj = 0; bj < 2; ++bj) {
                        const f32x4 a0 = acc[ai][bj][m][0] * rstd, a1 = acc[ai][bj][m][1] * rstd;
                        u32x4 w; w.x = pk2(a0[0], a0[1]); w.y = pk2(a0[2], a0[3]); w.z = pk2(a1[0], a1[1]); w.w = pk2(a1[2], a1[3]);
                        *(u32x4*)(p + (size_t)r * PW + col0 + bj * 128) = w;
                    }
                } else if (wc == 0 && fq == 0) {
                    *(f32x4*)(ab + (size_t)r * 8) = acc[ai][0][m][0] * rstd; *(f32x4*)(ab + (size_t)r * 8 + 4) = acc[ai][0][m][1] * rstd;
                }
            }
    }
};

__device__ __forceinline__ int map_row(int n, int mode) {
    if (mode == 1) return ((n >> 7) << 8) + (n & 127);
    if (mode == 2) return ((n >> 7) << 8) + 128 + (n & 127);
    if (mode == 3) return n < 2048 ? n : (n < 2056 ? 2560 + (n - 2048) : n - 8);
    return n;
}
__device__ __forceinline__ void tr_item(const float* W, int N, int K, bf16_t* WT, int item, int mode, const float* kscale, LAS float* scr, int lane) {
    const int nnb = (N + 31) >> 5, kb = item / nnb, nb = item - kb * nnb, k0 = kb * 64, n0 = nb * 32;
    const int nsrc = min(n0 + (lane & 31), N - 1);
    const float* wp = W + (size_t)(k0 + (lane >> 5)) * N + nsrc;
#pragma unroll
    for (int i0 = 0; i0 < 32; i0 += 16) {
        float v[16];
#pragma unroll
        for (int i = 0; i < 16; ++i) v[i] = __builtin_nontemporal_load(wp + (size_t)(2 * (i0 + i)) * N);
        if (kscale) {
#pragma unroll
            for (int i = 0; i < 16; ++i) v[i] *= kscale[k0 + 2 * (i0 + i) + (lane >> 5)];
        }
#pragma unroll
        for (int i = 0; i < 16; ++i) scr[(2 * (i0 + i) + (lane >> 5)) * 33 + (lane & 31)] = v[i];
    }
    LDS_WAIT();
    const int c = lane & 7;
#pragma unroll
    for (int j = 0; j < 4; ++j) {
        const int nl = (lane >> 3) + 8 * j, n = n0 + nl;
        const LAS float* s = scr + (8 * c) * 33 + nl;
        u32x4 o; o.x = pk2(s[0 * 33], s[1 * 33]); o.y = pk2(s[2 * 33], s[3 * 33]); o.z = pk2(s[4 * 33], s[5 * 33]); o.w = pk2(s[6 * 33], s[7 * 33]);
        if (n < N) *(u32x4*)(WT + (size_t)map_row(n, mode) * K + k0 + 8 * c) = o;
    }
    LDS_WAIT();
}
__device__ __forceinline__ void convert_weights(const Params& P, int set, int l, int widx, int nw, LAS float* scr, int lane) {
    constexpr int I_G = 16 * 88, I_D = 44 * 32, I_W = 16 * 81, I_O = 16 * 32;
    bf16_t* wx = (bf16_t*)(P.ws + WS_WX); bf16_t* wy = (bf16_t*)((unsigned char*)P.out + DO_WY);
    if (set == 0) {
        const float* nf = P.in[5] + l * D; const float* nm = P.in[9] + l * D;
        const float* wg = P.in[6] + (size_t)l * D * FF; const float* wu = P.in[7] + (size_t)l * D * FF; const float* wd = P.in[8] + (size_t)l * FF * D; const float* wi = P.in[10] + (size_t)l * D * 2568;
        for (int it = widx; it < 2 * I_G + I_D + I_W; it += nw) {
            int r = it;
            if (r < I_G) { tr_item(wg, FF, D, wx + WX_UP / 2, r, 1, nf, scr, lane); continue; } r -= I_G;
            if (r < I_G) { tr_item(wu, FF, D, wx + WX_UP / 2, r, 2, nf, scr, lane); continue; } r -= I_G;
            if (r < I_D) { tr_item(wd, D, FF, wx + WX_DOWN / 2, r, 0, nullptr, scr, lane); continue; } r -= I_D;
            tr_item(wi, 2568, D, wx + WX_WIN / 2, r, 3, nm, scr, lane);
        }
    } else {
        const float* nf = P.in[18] + l * D;
        const float* wo = P.in[17] + (size_t)l * D * D; const float* wg = P.in[19] + (size_t)l * D * FF; const float* wu = P.in[20] + (size_t)l * D * FF; const float* wd = P.in[21] + (size_t)l * FF * D;
        for (int it = widx; it < I_O + 2 * I_G + I_D; it += nw) {
            int r = it;
            if (r < I_O) { tr_item(wo, D, D, wy + WY_OUT / 2, r, 0, nullptr, scr, lane); continue; } r -= I_O;
            if (r < I_G) { tr_item(wg, FF, D, wy + WY_UP / 2, r, 1, nf, scr, lane); continue; } r -= I_G;
            if (r < I_G) { tr_item(wu, FF, D, wy + WY_UP / 2, r, 2, nf, scr, lane); continue; } r -= I_G;
            tr_item(wd, D, FF, wy + WY_DOWN / 2, r, 0, nullptr, scr, lane);
        }
    }
}

__device__ __forceinline__ void phase0(const Params& P, LAS unsigned char* lds, int tid0, int bid0) {
    const int tid = tid0, lane = tid & 63, wave = tid >> 6;
    const int gw = bid0 * 8 + wave, NGW = gridDim.x * 8;
    float* rowss = (float*)(P.ws + WS_ROWSS);
    bf16_t* xb = (bf16_t*)(P.ws + WS_XB);
    for (int r0 = gw; r0 < M; r0 += 4 * NGW) {
        f32x4 v[4][4];
#pragma unroll
        for (int u = 0; u < 4; ++u) {
            const int r = min(r0 + u * NGW, M - 1);
            const float* src = r < MP ? P.in[0] + (size_t)r * D : P.in[1] + (size_t)(r - MP) * D;
            const f32x4* xr = (const f32x4*)src + lane;
#pragma unroll
            for (int j = 0; j < 4; ++j) v[u][j] = __builtin_nontemporal_load(xr + 64 * j);
        }
#pragma unroll
        for (int u = 0; u < 4; ++u) {
            const int r = r0 + u * NGW;
            if (r < M) {
                float s = 0.f;
#pragma unroll
                for (int j = 0; j < 4; ++j) s += (v[u][j].x * v[u][j].x + v[u][j].y * v[u][j].y) + (v[u][j].z * v[u][j].z + v[u][j].w * v[u][j].w);
                s = wave_sum(s);
                if (lane == 0) ((float*)(P.ws + WS_RSTD))[r] = rsqrtf(s * (1.f / 1024.f) + 1e-6f);
                u32x2* o8 = (u32x2*)(xb + (size_t)r * D) + lane;
#pragma unroll
                for (int j = 0; j < 4; ++j) { u32x2 w; w.x = pk2(v[u][j].x, v[u][j].y); w.y = pk2(v[u][j].z, v[u][j].w); o8[64 * j] = w; }
            }
        }
    }
    LAS float* scr = (LAS float*)(lds + wave * 16384);
    convert_weights(P, 0, 0, gw, NGW, scr, lane);
    convert_weights(P, 1, 0, gw, NGW, scr, lane);
    bf16_t* wpt = (bf16_t*)(P.ws + WS_WPT);
    for (int it = gw; it < 64; it += NGW) { const int mat = it >> 3; tr_item(P.in[15] + mat * 16384, 128, 128, wpt + mat * 16384, it & 7, 0, nullptr, scr, lane); }
}

__device__ __forceinline__ void d1_task(const Params& P, int l, int task, LAS unsigned char* lds, int tid0, int bid0) {
    int tidl = tid0; asm volatile("" : "+v"(tidl));
    const int tid = tidl, lane = tid & 63, wave = tid >> 6;
    const int c = task >> 2, h = task & 3;
    const bool samp = c >= 256; const int sb = c - 256;
    const int row0 = samp ? MP + sb * 16 : c * 64, nvalid = samp ? 16 : 64;
    const int bq = c >> 7, nq = c & 127;
    LAS float* sV = (LAS float*)lds;
    LAS bf16_t* sK = (LAS bf16_t*)(lds + 32768);
    LAS bf16_t* sQ = (LAS bf16_t*)(lds + 50176);
    LAS float* sGc = (LAS float*)(lds + 67584);
    LAS float* sBeta = sGc + 64; LAS float* sEg = sGc + 128; LAS float* sGl = sGc + 192;
    LAS float* sCW = (LAS float*)(lds + 68608);
    LAS bf16_t* sRaw = (LAS bf16_t*)(lds + 74752);
    LAS float* sAT = (LAS float*)(lds + 74752);
    const bf16_t* p = (const bf16_t*)(P.ws + WS_AREG);
    const float* ab = (const float*)(P.ws + WS_AB);
    const float* convw = P.in[11] + (size_t)l * 4 * 1536;
    const float* sconv = P.in[3] + (size_t)(l * 16 + (samp ? sb : 0)) * 3 * 1536;
    bf16_t* d1 = (bf16_t*)(P.ws + WS_D1) + (size_t)task * 32768;
    bf16_t* qkb = (bf16_t*)((unsigned char*)P.out + DO_QK) + (size_t)task * 4096;
    {
        u32x4 st[7];
#pragma unroll
        for (int q = 0; q < 7; ++q) {
            const int idx = q * 512 + tid;
            u32x4 v = (u32x4){0u, 0u, 0u, 0u};
            if (idx < 67 * 48) {
                const int rrow = idx / 48, pc = idx - rrow * 48, col = (pc >> 4) * 512 + h * 128 + (pc & 15) * 8, rel = rrow - 3;
                if (!samp) {
                    const int pos = nq * 64 + rel;
                    if (pos >= 0) v = *(const u32x4*)(p + (size_t)(bq * SEQ + pos) * PW + col);
                } else if (rel < 0) {
                    const float* sp = sconv + (3 + rel) * 1536 + col;
                    const f32x4 q0 = *(const f32x4*)sp, q1 = *(const f32x4*)(sp + 4);
                    v.x = pk2(q0.x, q0.y); v.y = pk2(q0.z, q0.w); v.z = pk2(q1.x, q1.y); v.w = pk2(q1.z, q1.w);
                } else if (rel < 16) v = *(const u32x4*)(p + (size_t)(row0 + rel) * PW + col);
            }
            st[q] = v;
        }
        f32x4 cw = (f32x4){0.f, 0.f, 0.f, 0.f};
        if (tid < 384) { const int tap = tid / 96, c4 = tid - tap * 96; cw = *(const f32x4*)(convw + tap * 1536 + (c4 / 32) * 512 + h * 128 + (c4 & 31) * 4); }
#pragma unroll
        for (int q = 0; q < 7; ++q) { const int idx = q * 512 + tid; if (idx < 67 * 48) *(LAS u32x4*)(sRaw + idx * 8) = st[q]; }
        if (tid < 384) *(LAS f32x4*)(sCW + tid * 4) = cw;
    }
    if (tid < 64) {
        const int j = tid; float beta = 0.f, gv = 0.f;
        if (j < nvalid) {
            const float a = ab[(size_t)(row0 + j) * 8 + h], bb = ab[(size_t)(row0 + j) * 8 + 4 + h];
            beta = 1.f / (1.f + __expf(-bb));
            const float x = a + P.in[13][l * 4 + h];
            const float sp = x > 20.f ? x : log1pf(__expf(x));
            gv = -__expf(P.in[12][l * 4 + h]) * sp;
        }
#pragma unroll
        for (int o = 1; o < 64; o <<= 1) { const float t = __shfl_up(gv, o); if (lane >= o) gv += t; }
        sGc[j] = gv; sBeta[j] = beta; sEg[j] = __expf(gv);
        if (j == 63) { sGl[0] = gv; ((float*)(P.ws + WS_GL))[task] = __expf(gv); }
    }
    __syncthreads();
    {
        const int rr = tid >> 4, l16 = tid & 15;
#pragma unroll 1
        for (int pass = 0; pass < 2; ++pass) {
            const int i = rr + 32 * pass;
            const bool valid = i < nvalid;
#pragma unroll
            for (int t = 0; t < 3; ++t) {
                float a8[8];
#pragma unroll
                for (int e = 0; e < 8; ++e) a8[e] = 0.f;
                if (valid) {
#pragma unroll
                    for (int tap = 0; tap < 4; ++tap) {
                        const u32x4 q = *(const LAS u32x4*)(sRaw + (i + tap) * 384 + t * 128 + l16 * 8);
                        const f32x4 w0 = *(const LAS f32x4*)(sCW + tap * 384 + t * 128 + l16 * 8), w1 = *(const LAS f32x4*)(sCW + tap * 384 + t * 128 + l16 * 8 + 4);
                        a8[0] += bflo(q.x) * w0.x; a8[1] += bfhi(q.x) * w0.y; a8[2] += bflo(q.y) * w0.z; a8[3] += bfhi(q.y) * w0.w;
                        a8[4] += bflo(q.z) * w1.x; a8[5] += bfhi(q.z) * w1.y; a8[6] += bflo(q.w) * w1.z; a8[7] += bfhi(q.w) * w1.w;
                        if (tap == 3) {
                            float* dst = nullptr; const int col = t * 512 + h * 128 + l16 * 8;
                            if (!samp) { if (nq == 127 && i >= 61) dst = P.out + O_PC + (size_t)((l * 2 + bq) * 3 + (i - 61)) * 1536 + col; }
                            else if (i >= 13) dst = P.out + O_SC + (size_t)((l * 16 + sb) * 3 + (i - 13)) * 1536 + col;
                            if (dst) { *(f32x4*)dst = (f32x4){bflo(q.x), bfhi(q.x), bflo(q.y), bfhi(q.y)}; *(f32x4*)(dst + 4) = (f32x4){bflo(q.z), bfhi(q.z), bflo(q.w), bfhi(q.w)}; }
                        }
                    }
#pragma unroll
                    for (int e = 0; e < 8; ++e) a8[e] = silu_f(a8[e]);
                }
                if (t < 2) {
                    float ss = 0.f;
#pragma unroll
                    for (int e = 0; e < 8; ++e) ss += a8[e] * a8[e];
                    ss = red16(ss);
                    float sc = rsqrtf(ss + EPS); if (t == 0) sc *= 0.08838834764831845f;
                    u32x4 w; w.x = pk2(a8[0] * sc, a8[1] * sc); w.y = pk2(a8[2] * sc, a8[3] * sc); w.z = pk2(a8[4] * sc, a8[5] * sc); w.w = pk2(a8[6] * sc, a8[7] * sc);
                    *(LAS u32x4*)((t == 0 ? sQ : sK) + i * 136 + l16 * 8) = w;
                } else {
                    *(LAS f32x4*)(sV + i * 128 + l16 * 8) = (f32x4){a8[0], a8[1], a8[2], a8[3]};
                    *(LAS f32x4*)(sV + i * 128 + l16 * 8 + 4) = (f32x4){a8[4], a8[5], a8[6], a8[7]};
                }
            }
        }
    }
    __syncthreads();
    {
        const int n = lane & 15, g = lane >> 4, mi = wave >> 1, nb = (wave & 1) * 2;
        f32x4 akk[2], aqk[2];
#pragma unroll
        for (int t = 0; t < 2; ++t) { akk[t] = (f32x4){0.f, 0.f, 0.f, 0.f}; aqk[t] = (f32x4){0.f, 0.f, 0.f, 0.f}; }
#pragma unroll
        for (int kk = 0; kk < 4; ++kk) {
            const bf16x8 ak = *(const LAS bf16x8*)(sK + (mi * 16 + n) * 136 + kk * 32 + g * 8);
            const bf16x8 aq = *(const LAS bf16x8*)(sQ + (mi * 16 + n) * 136 + kk * 32 + g * 8);
#pragma unroll
            for (int t = 0; t < 2; ++t) {
                const bf16x8 bk = *(const LAS bf16x8*)(sK + ((nb + t) * 16 + n) * 136 + kk * 32 + g * 8);
                akk[t] = MFMA16(ak, bk, akk[t]); aqk[t] = MFMA16(aq, bk, aqk[t]);
            }
        }
#pragma unroll
        for (int t = 0; t < 2; ++t) {
            const int j = (nb + t) * 16 + n; const float gcj = sGc[j];
#pragma unroll
            for (int r = 0; r < 4; ++r) {
                const int i = mi * 16 + g * 4 + r;
                const float dec = (i >= j) ? __expf(sGc[i] - gcj) : 0.f;
                sAT[j * 64 + i] = (i > j) ? sBeta[i] * akk[t][r] * dec : 0.f;
                qkb[i * 64 + j] = f2bf(aqk[t][r] * dec);
            }
        }
    }
    __syncthreads();
    if (tid < 256) {
        int z; asm volatile("v_mov_b32 %0, 0" : "=v"(z));
        const LAS float* sATz = sAT + z; const LAS float* sBz = sBeta + z; const LAS float* sEz = sEg + z;
        float r[64];
        if (tid < 128) {
#pragma unroll
            for (int i = 0; i < 64; ++i) r[i] = sV[i * 128 + tid] * sBz[i];
        } else {
#pragma unroll
            for (int i = 0; i < 64; ++i) r[i] = bf2f(sK[i * 136 + tid - 128]) * sBz[i] * sEz[i];
        }
#pragma unroll
        for (int j = 0; j < 63; ++j) {
            const float rj = r[j];
            f32x4 a4[16];
#pragma unroll
            for (int q = (j + 1) / 4; q < 16; ++q) a4[q] = *(const LAS f32x4*)(sATz + j * 64 + q * 4);
#pragma unroll
            for (int i = j + 1; i < 64; ++i) r[i] -= a4[i >> 2][i & 3] * rj;
            __builtin_amdgcn_sched_barrier(0);
        }
        if (tid < 128) {
            bf16_t* uT = d1 + 24576 + tid * 64;
#pragma unroll
            for (int q = 0; q < 8; ++q) { u32x4 w; w.x = pk2(r[q * 8], r[q * 8 + 1]); w.y = pk2(r[q * 8 + 2], r[q * 8 + 3]); w.z = pk2(r[q * 8 + 4], r[q * 8 + 5]); w.w = pk2(r[q * 8 + 6], r[q * 8 + 7]); *(u32x4*)(uT + q * 8) = w; }
        } else {
            const int d = tid - 128, rem = d & 31;
            bf16_t* wcol = d1 + ((d >> 5) * 32 + ((rem & 15) >> 2) * 8 + (rem >> 4) * 4 + (rem & 3));
#pragma unroll
            for (int i = 0; i < 64; ++i) wcol[i * 128] = f2bf(r[i]);
        }
    } else {
        const int tt = tid - 256;
        {
            const int i = tt >> 2, d0 = (tt & 3) * 32; const float eg = sEg[i];
#pragma unroll
            for (int q = 0; q < 4; ++q) {
                const u32x4 v = *(const LAS u32x4*)(sQ + i * 136 + d0 + q * 8);
                u32x4 w; w.x = pk2(bflo(v.x) * eg, bfhi(v.x) * eg); w.y = pk2(bflo(v.y) * eg, bfhi(v.y) * eg); w.z = pk2(bflo(v.z) * eg, bfhi(v.z) * eg); w.w = pk2(bflo(v.w) * eg, bfhi(v.w) * eg);
                *(u32x4*)(d1 + 16384 + i * 128 + d0 + q * 8) = w;
            }
        }
        {
            const int d = tt >> 1, j0 = (tt & 1) * 32; const float gl = sGl[0];
#pragma unroll
            for (int q = 0; q < 4; ++q) {
                float v[8];
#pragma unroll
                for (int e = 0; e < 8; ++e) { const int j = j0 + 4 * q + (e & 3) + 16 * (e >> 2); v[e] = bf2f(sK[j * 136 + d]) * __expf(gl - sGc[j]); }
                u32x4 w; w.x = pk2(v[0], v[1]); w.y = pk2(v[2], v[3]); w.z = pk2(v[4], v[5]); w.w = pk2(v[6], v[7]);
                *(u32x4*)(d1 + 8192 + d * 64 + j0 + q * 8) = w;
            }
        }
    }
    __syncthreads();
}

__device__ __forceinline__ void pool_task(const Params& P, int l, int ptask, LAS unsigned char* lds, int tid0, int bid0) {
    int tidl = tid0; asm volatile("" : "+v"(tidl));
    const int tid = tidl, lane = tid & 63, wave = tid >> 6;
    const int c = ptask >> 2, gi = ptask & 3, win = 2 << gi;
    const bool samp = c >= 256; const int sb = c - 256;
    const int row0 = samp ? MP + sb * 16 : c * 64, nvalid = samp ? 16 : 64;
    const int bq = c >> 7, nq = c & 127;
    LAS float* sU = (LAS float*)lds;
    LAS bf16_t* sD = (LAS bf16_t*)(lds + 50560);
    const bf16_t* p = (const bf16_t*)(P.ws + WS_AREG);
    bf16_t* mix = (bf16_t*)(P.ws + WS_MIX);
    {
        u32x4 st[3]; f32x4 sf0[3], sf1[3];
#pragma unroll
        for (int q = 0; q < 3; ++q) {
            const int idx = q * 512 + tid; st[q] = (u32x4){0u, 0u, 0u, 0u}; sf0[q] = (f32x4){0.f, 0.f, 0.f, 0.f}; sf1[q] = sf0[q];
            if (idx < 79 * 16) {
                const int rrow = idx >> 4, pc = idx & 15, rel = rrow - 15, ch = gi * 128 + pc * 8;
                if (!samp) { const int pos = nq * 64 + rel; if (pos >= 0) st[q] = *(const u32x4*)(p + (size_t)(bq * SEQ + pos) * PW + 2048 + ch); }
                else if (rel < 0) { const float* sp = P.in[4] + (size_t)((l * 16 + sb) * 15 + 15 + rel) * 512 + ch; sf0[q] = *(const f32x4*)sp; sf1[q] = *(const f32x4*)(sp + 4); }
                else if (rel < 16) st[q] = *(const u32x4*)(p + (size_t)(row0 + rel) * PW + 2048 + ch);
            }
        }
#pragma unroll
        for (int q = 0; q < 3; ++q) {
            const int idx = q * 512 + tid;
            if (idx < 79 * 16) {
                const int rrow = idx >> 4, pc = idx & 15;
                f32x4 v0, v1;
                if (samp && rrow < 15) { v0 = sf0[q]; v1 = sf1[q]; }
                else { v0 = (f32x4){bflo(st[q].x), bfhi(st[q].x), bflo(st[q].y), bfhi(st[q].y)}; v1 = (f32x4){bflo(st[q].z), bfhi(st[q].z), bflo(st[q].w), bfhi(st[q].w)}; }
                *(LAS f32x4*)(sU + rrow * 160 + pc * 8) = v0; *(LAS f32x4*)(sU + rrow * 160 + pc * 8 + 4) = v1;
            }
        }
    }
    __syncthreads();
    {
        const int i = tid >> 3, l8 = tid & 7;
        const int have_n = samp ? win : min(win, nq * 64 + i + 1);
        const float inv = 1.f / (float)have_n;
#pragma unroll
        for (int q = 0; q < 4; ++q) {
            const int ch = q * 32 + l8 * 4;
            f32x4 sum = (f32x4){0.f, 0.f, 0.f, 0.f};
            const f32x4 cur = *(const LAS f32x4*)(sU + (15 + i) * 160 + ch);
            for (int t = 0; t < win; ++t) sum += *(const LAS f32x4*)(sU + (15 + i - t) * 160 + ch);
            const f32x4 d = (i < nvalid) ? sum * inv - cur : (f32x4){0.f, 0.f, 0.f, 0.f};
            u32x2 w; w.x = pk2(d.x, d.y); w.y = pk2(d.z, d.w);
            *(LAS u32x2*)(sD + i * 136 + ch) = w;
            float* dst = nullptr;
            if (!samp) { if (nq == 127 && i >= 49) dst = P.out + O_PP + (size_t)((l * 2 + bq) * 15 + (i - 49)) * 512 + gi * 128 + ch; }
            else if (i >= 1 && i < 16) dst = P.out + O_SP + (size_t)((l * 16 + sb) * 15 + (i - 1)) * 512 + gi * 128 + ch;
            if (dst) *(f32x4*)dst = cur;
        }
    }
    __syncthreads();
    {
        const int n = lane & 15, g = lane >> 4, ni = wave;
        const bf16_t* wpt = (const bf16_t*)(P.ws + WS_WPT) + (size_t)(l * 4 + gi) * 16384;
        f32x4 acc[4];
#pragma unroll
        for (int mi = 0; mi < 4; ++mi) acc[mi] = (f32x4){0.f, 0.f, 0.f, 0.f};
#pragma unroll
        for (int kk = 0; kk < 4; ++kk) {
            const bf16x8 b = *(const bf16x8*)(wpt + (ni * 16 + n) * 128 + kk * 32 + g * 8);
#pragma unroll
            for (int mi = 0; mi < 4; ++mi) { const bf16x8 a = *(const LAS bf16x8*)(sD + (mi * 16 + n) * 136 + kk * 32 + g * 8); acc[mi] = MFMA16(a, b, acc[mi]); }
        }
        const int dcol = gi * 128 + ni * 16 + n; const float sc = P.in[16][l * 512 + dcol];
#pragma unroll
        for (int mi = 0; mi < 4; ++mi)
#pragma unroll
            for (int r = 0; r < 4; ++r) { const int i = mi * 16 + g * 4 + r; if (i < nvalid) mix[(size_t)(row0 + i) * D + 512 + dcol] = f2bf(acc[mi][r] * sc); }
    }
    __syncthreads();
}

__device__ __forceinline__ void d2h_dma(const bf16_t* d1, int c0, LAS unsigned char* buf, int hw, int lane) {
#pragma unroll
    for (int q = 0; q < 10; ++q) {
        const int sl = q * 256 + hw * 64 + lane;
        const bf16_t* src;
        if (q < 4) { const int r = sl >> 4, c = (sl & 15) ^ (r & 15); src = d1 + r * 128 + c * 8; }
        else if (q < 8) { const int s2 = sl - 1024, r = s2 >> 3, c = (s2 & 7) ^ (r & 7); src = d1 + 8192 + r * 64 + c * 8; }
        else { const int s2 = sl - 2048, r = s2 >> 3, c = (s2 & 7) ^ (r & 7); src = d1 + 24576 + (c0 + r) * 64 + c * 8; }
        __builtin_amdgcn_global_load_lds((const unsigned*)src, (LAS unsigned*)(buf + (q * 256 + hw * 64) * 16), 16, 0, 0);
    }
}
__device__ __forceinline__ void d2c_drain(const Params& P, LAS unsigned char* sb, int task, int col0, int lane) {
    bf16_t* d1 = (bf16_t*)(P.ws + WS_D1) + (size_t)task * 32768;
    bf16_t* snt = (bf16_t*)((unsigned char*)P.out + DO_SNT) + (size_t)task * 16384;
    u32x4 v[6];
#pragma unroll
    for (int q = 0; q < 4; ++q) { const int L = q * 64 + lane, row = L >> 4, c = L & 15; v[q] = *(const LAS u32x4*)(sb + row * 256 + ((c ^ row) * 16)); }
#pragma unroll
    for (int q = 0; q < 2; ++q) { const int L = q * 64 + lane, row = L >> 3, c = L & 7; v[4 + q] = *(const LAS u32x4*)(sb + 4096 + row * 128 + ((c ^ (row & 7)) * 16)); }
#pragma unroll
    for (int q = 0; q < 4; ++q) *(u32x4*)(snt + col0 * 128 + (q * 64 + lane) * 8) = v[q];
#pragma unroll
    for (int q = 0; q < 2; ++q) *(u32x4*)(d1 + 24576 + col0 * 64 + (q * 64 + lane) * 8) = v[4 + q];
}
__device__ __forceinline__ void d2c_step(LAS unsigned char* buf, LAS unsigned char* stg, float egc, int e0l, int n, int g, f32x4 (&S)[8]) {
    u32x2 uu[4]; bf16x8 Af[4][4];
#pragma unroll
    for (int mt = 0; mt < 4; ++mt) { const int r = e0l + n, c = mt * 2 + (g >> 1); uu[mt] = *(const LAS u32x2*)(buf + 32768 + (r * 8 + (c ^ (r & 7))) * 16 + (g & 1) * 8); }
#pragma unroll
    for (int s = 0; s < 4; ++s)
#pragma unroll
        for (int mt = 0; mt < 4; ++mt) { const int r = mt * 16 + n; Af[s][mt] = *(const LAS bf16x8*)(buf + (r * 16 + ((s * 4 + g) ^ (r & 15))) * 16); }
    u32x2 Pk[8];
#pragma unroll
    for (int mt = 0; mt < 8; ++mt) { Pk[mt].x = pk2(S[mt][0], S[mt][1]); Pk[mt].y = pk2(S[mt][2], S[mt][3]); }
#pragma unroll
    for (int mt = 0; mt < 8; ++mt) *(LAS u32x2*)(stg + n * 256 + (((mt * 2 + (g >> 1)) ^ n) * 16) + (g & 1) * 8) = Pk[mt];
    __builtin_amdgcn_sched_barrier(0);
    f32x4 vt[4];
#pragma unroll
    for (int mt = 0; mt < 4; ++mt) vt[mt] = (f32x4){-bflo(uu[mt].x), -bfhi(uu[mt].x), -bflo(uu[mt].y), -bfhi(uu[mt].y)};
#pragma unroll
    for (int s = 0; s < 4; ++s) {
        u32x4 bv; bv.x = Pk[2 * s].x; bv.y = Pk[2 * s].y; bv.z = Pk[2 * s + 1].x; bv.w = Pk[2 * s + 1].y;
        const bf16x8 bf = __builtin_bit_cast(bf16x8, bv);
#pragma unroll
        for (int mt = 0; mt < 4; ++mt) vt[mt] = MFMA16(Af[s][mt], bf, vt[mt]);
    }
    __builtin_amdgcn_sched_barrier(0);
    bf16x8 Kf[8][2];
#pragma unroll
    for (int mt = 0; mt < 8; ++mt)
#pragma unroll
        for (int s = 0; s < 2; ++s) { const int r = mt * 16 + n; Kf[mt][s] = *(const LAS bf16x8*)(buf + 16384 + (r * 8 + ((s * 4 + g) ^ (r & 7))) * 16); }
#pragma unroll
    for (int mt = 0; mt < 8; ++mt) S[mt] = S[mt] * egc;
    __builtin_amdgcn_sched_barrier(0);
    u32x2 Vp[4];
#pragma unroll
    for (int mt = 0; mt < 4; ++mt) {
        Vp[mt].x = pk2(-vt[mt][0], -vt[mt][1]); Vp[mt].y = pk2(-vt[mt][2], -vt[mt][3]);
        *(LAS u32x2*)(stg + 4096 + n * 128 + (((mt * 2 + (g >> 1)) ^ (n & 7)) * 16) + (g & 1) * 8) = Vp[mt];
    }
    bf16x8 vb[2];
#pragma unroll
    for (int s = 0; s < 2; ++s) { u32x4 bv; bv.x = Vp[2 * s].x; bv.y = Vp[2 * s].y; bv.z = Vp[2 * s + 1].x; bv.w = Vp[2 * s + 1].y; vb[s] = __builtin_bit_cast(bf16x8, bv); }
#pragma unroll
    for (int s = 0; s < 2; ++s)
#pragma unroll
        for (int mt = 0; mt < 8; ++mt) S[mt] = MFMA16(Kf[mt][s], vb[s], S[mt]);
}
#define D2_BAR() do { asm volatile("s_waitcnt lgkmcnt(0)" ::: "memory"); __builtin_amdgcn_s_barrier(); asm volatile("" ::: "memory"); } while (0)
__device__ __forceinline__ void d2_seq(const Params& P, LAS unsigned char* lds, int chunk0, int nch, int h, int c0, const float* s0, float* sout, int tid0, int bid0) {
    const int tid = tid0, lane = tid & 63, wave = tid >> 6, n = lane & 15, g = lane >> 4;
    const bool comp = wave < 4;
    const int e0l = (wave & 3) * 16, hw = __builtin_amdgcn_readfirstlane(wave & 3);
    const int task0 = chunk0 * 4 + h;
    const bf16_t* d1base = (const bf16_t*)(P.ws + WS_D1) + (size_t)task0 * 32768;
    constexpr size_t TS = 4 * 32768;
    LAS unsigned char* stgw = lds + 122880 + (wave & 3) * 6144;
    LAS float* sEG = (LAS float*)(lds + 147456);
    f32x4 S[8];
    const int last = nch - 1;
    if (comp) {
#pragma unroll
        for (int mt = 0; mt < 8; ++mt)
#pragma unroll
            for (int r = 0; r < 4; ++r) S[mt][r] = s0 ? s0[(mt * 16 + g * 4 + r) * 128 + c0 + e0l + n] : 0.f;
    } else {
        d2h_dma(d1base, c0, lds, hw, lane);
        d2h_dma(d1base + (size_t)min(1, last) * TS, c0, lds + 40960, hw, lane);
        asm volatile("s_waitcnt vmcnt(10)" ::: "memory");
    }
    if (tid < nch) sEG[tid] = ((const float*)(P.ws + WS_GL))[task0 + 4 * tid];
    D2_BAR();
    int rb = 0;
#pragma unroll 1
    for (int ci = 0; ci < nch; ++ci) {
        LAS unsigned char* cur = lds + rb * 40960;
        const int rb2 = rb >= 1 ? rb - 1 : 2;
        if (comp) {
            d2c_step(cur, stgw, sEG[ci], e0l, n, g, S);
            asm volatile("s_waitcnt lgkmcnt(0)" ::: "memory");
            d2c_drain(P, stgw, task0 + ci * 4, c0 + e0l, lane);
        } else {
            int ll = lane; asm volatile("" : "+v"(ll));
            d2h_dma(d1base + (size_t)min(ci + 2, last) * TS, c0, lds + rb2 * 40960, hw, ll);
            asm volatile("s_waitcnt vmcnt(10)" ::: "memory");
        }
        D2_BAR();
        rb = rb == 2 ? 0 : rb + 1;
    }
    if (comp) {
#pragma unroll
        for (int mt = 0; mt < 8; ++mt)
#pragma unroll
            for (int r = 0; r < 4; ++r) sout[(mt * 16 + g * 4 + r) * 128 + c0 + e0l + n] = S[mt][r];
    } else {
        asm volatile("s_waitcnt vmcnt(0)" ::: "memory");
    }
    D2_BAR();
}

__device__ __forceinline__ void d3_task(const Params& P, int l, int task, LAS unsigned char* lds, int tid0, int bid0) {
    int tidl = tid0; asm volatile("" : "+v"(tidl));
    const int tid = tidl, lane = tid & 63, wave = tid >> 6;
    const int c = task >> 2, h = task & 3;
    const bool samp = c >= 256; const int sb = c - 256;
    const int row0 = samp ? MP + sb * 16 : c * 64, nvalid = samp ? 16 : 64;
    const int n = lane & 15, g = lane >> 4, e0 = wave * 16;
    LAS bf16_t* sGate = (LAS bf16_t*)(lds + 73728); LAS bf16_t* sOut = (LAS bf16_t*)(lds + 90112); LAS float* sSS = (LAS float*)(lds + 106496);
    const bf16_t* d1 = (const bf16_t*)(P.ws + WS_D1) + (size_t)task * 32768;
    const bf16_t* snt = (const bf16_t*)((unsigned char*)P.out + DO_SNT) + (size_t)task * 16384;
    const bf16_t* qkb = (const bf16_t*)((unsigned char*)P.out + DO_QK) + (size_t)task * 4096;
    const bf16_t* p = (const bf16_t*)(P.ws + WS_AREG);
    bf16_t* mix = (bf16_t*)(P.ws + WS_MIX);
    {
        u32x4 st[11];
#pragma unroll
        for (int q = 0; q < 11; ++q) {
            const int idx = q * 512 + tid;
            const bf16_t* src;
            if (q < 2) src = d1 + 16384 + idx * 8;
            else if (q < 6) src = snt + (idx - 1024) * 8;
            else if (q < 7) src = qkb + (idx - 3072) * 8;
            else if (q < 9) src = d1 + 24576 + (idx - 3584) * 8;
            else { const int i5 = idx - 4608, r = min(i5 >> 4, nvalid - 1); src = p + (size_t)(row0 + r) * PW + 1536 + h * 128 + (i5 & 15) * 8; }
            st[q] = *(const u32x4*)src;
        }
#pragma unroll
        for (int q = 0; q < 11; ++q) {
            const int idx = q * 512 + tid;
            int off;
            if (q < 2) { const int r = idx >> 4, cc = idx & 15; off = (r * 16 + (cc ^ (r & 15))) * 16; }
            else if (q < 6) { const int i2 = idx - 1024, r = i2 >> 4, cc = i2 & 15; off = 16384 + (r * 16 + (cc ^ (r & 15))) * 16; }
            else if (q < 7) { const int i3 = idx - 3072, r = i3 >> 3, cc = i3 & 7; off = 49152 + (r * 8 + (cc ^ (r & 7))) * 16; }
            else if (q < 9) { const int i4 = idx - 3584, r = i4 >> 3, cc = i4 & 7; off = 57344 + (r * 8 + (cc ^ (r & 7))) * 16; }
            else off = 73728 + (idx - 4608) * 16;
            *(LAS u32x4*)(lds + off) = st[q];
        }
    }
    __syncthreads();
    f32x4 acc[4];
#pragma unroll
    for (int mt = 0; mt < 4; ++mt) acc[mt] = (f32x4){0.f, 0.f, 0.f, 0.f};
#pragma unroll
    for (int kk = 0; kk < 4; ++kk) {
        const int rb = e0 + n;
        const bf16x8 b = *(const LAS bf16x8*)(lds + 16384 + (rb * 16 + ((kk * 4 + g) ^ (rb & 15))) * 16);
#pragma unroll
        for (int mt = 0; mt < 4; ++mt) { const int r = mt * 16 + n; const bf16x8 a = *(const LAS bf16x8*)(lds + (r * 16 + ((kk * 4 + g) ^ (r & 15))) * 16); acc[mt] = MFMA16(a, b, acc[mt]); }
    }
#pragma unroll
    for (int kk = 0; kk < 2; ++kk) {
        const int rb = e0 + n;
        const bf16x8 b = *(const LAS bf16x8*)(lds + 57344 + (rb * 8 + ((kk * 4 + g) ^ (rb & 7))) * 16);
#pragma unroll
        for (int mt = 0; mt < 4; ++mt) { const int r = mt * 16 + n; const bf16x8 a = *(const LAS bf16x8*)(lds + 49152 + (r * 8 + ((kk * 4 + g) ^ (r & 7))) * 16); acc[mt] = MFMA16(a, b, acc[mt]); }
    }
#pragma unroll
    for (int mt = 0; mt < 4; ++mt)
#pragma unroll
        for (int r = 0; r < 4; ++r) {
            float ss = acc[mt][r] * acc[mt][r];
            ss = red16(ss);
            if (n == 0) sSS[wave * 64 + mt * 16 + g * 4 + r] = ss;
        }
    __syncthreads();
    const float onw = P.in[14][l * 128 + e0 + n];
#pragma unroll
    for (int mt = 0; mt < 4; ++mt)
#pragma unroll
        for (int r = 0; r < 4; ++r) {
            const int i = mt * 16 + g * 4 + r;
            float tot = 0.f;
#pragma unroll
            for (int w = 0; w < 8; ++w) tot += sSS[w * 64 + i];
            const float rstd = rsqrtf(tot * (1.f / 128.f) + EPS);
            const float gt = bf2f(sGate[i * 128 + e0 + n]);
            sOut[i * 128 + e0 + n] = f2bf(acc[mt][r] * rstd * onw * silu_f(gt));
        }
    __syncthreads();
#pragma unroll
    for (int q = 0; q < 2; ++q) {
        const int idx = q * 512 + tid, i = idx >> 4, cc = idx & 15;
        if (i < nvalid) *(u32x4*)(mix + (size_t)(row0 + i) * D + h * 128 + cc * 8) = *(const LAS u32x4*)(sOut + i * 128 + cc * 8);
    }
    __syncthreads();
}

__global__ void __launch_bounds__(512, 2) fwd_kernel(Params P) {
    extern __shared__ __attribute__((aligned(16))) unsigned char lds_raw[];
    LAS unsigned char* lds = (LAS unsigned char*)lds_raw;
    cg::grid_group grid = cg::this_grid();
    const int G = gridDim.x;
    volatile LAS unsigned* barw = (volatile LAS unsigned*)(lds + LDS_BARW);
    if (threadIdx.x < 4) barw[threadIdx.x] = 0u;
    __syncthreads();
    XcdBarrier xbar; xbar.bar = (unsigned*)(P.ws + WS_BAR); xbar.x = 0; xbar.st = barw;
    const bool multi = P.ph_hi - P.ph_lo > 1;
    if (multi) xbar = xcd_barrier_post((unsigned*)(P.ws + WS_BAR), barw);
    if (P.ph_hi > 1000) grid.sync();
    float* rowss = (float*)(P.ws + WS_ROWSS);
    float* rstdarr = (float*)(P.ws + WS_RSTD);
    bf16_t* xb = (bf16_t*)(P.ws + WS_XB);
    bf16_t* areg = (bf16_t*)(P.ws + WS_AREG);
    bf16_t* wx = (bf16_t*)(P.ws + WS_WX);
    bf16_t* wy = (bf16_t*)((unsigned char*)P.out + DO_WY);
#pragma unroll 1
    for (int ph = P.ph_lo; ph < P.ph_hi; ++ph) {
        int nrep = 1;
#if PROBE_REP
        if (ph > 0 && ph < NPH - 1) { const int k0 = (ph - 1) % 9; if ((PROBE_REP >> k0) & 1) nrep = (k0 == 4) ? 3 : 2; }
#endif
#pragma unroll 1
        for (int rep = 0; rep < nrep; ++rep) {
        int tid = threadIdx.x; asm volatile("" : "+v"(tid));
        int bid = blockIdx.x; asm volatile("" : "+s"(bid));
        const int lane = tid & 63, wave = tid >> 6;
        if ((PHM & 1) && ph == 0) {
            phase0(P, lds, tid, bid);
        } else if ((PHM & 2) && ph == NPH - 1) {
            const float* nf = P.in[22]; const float* rs = rstdarr + (size_t)6 * M;
            f32x4 w0[2], w1[2];
#pragma unroll
            for (int j = 0; j < 2; ++j) { const int cc = (lane + 64 * j) * 8; w0[j] = *(const f32x4*)(nf + cc); w1[j] = *(const f32x4*)(nf + cc + 4); }
            for (int r0 = bid * 8 + wave; r0 < M; r0 += 4 * G * 8) {
                u32x4 xv[4][2]; float rstd[4];
#pragma unroll
                for (int u = 0; u < 4; ++u) {
                    const int r = min(r0 + u * G * 8, M - 1);
                    rstd[u] = rs[r];
#pragma unroll
                    for (int j = 0; j < 2; ++j) xv[u][j] = *(const u32x4*)(xb + (size_t)r * D + (lane + 64 * j) * 8);
                }
#pragma unroll
                for (int u = 0; u < 4; ++u) {
                    const int r = r0 + u * G * 8;
                    if (r < M) {
#pragma unroll
                        for (int j = 0; j < 2; ++j) {
                            const int cc = (lane + 64 * j) * 8; const u32x4 q = xv[u][j];
                            __builtin_nontemporal_store((f32x4){bflo(q.x), bfhi(q.x), bflo(q.y), bfhi(q.y)} * rstd[u] * w0[j], (f32x4*)(P.out + (size_t)r * D + cc));
                            __builtin_nontemporal_store((f32x4){bflo(q.z), bfhi(q.z), bflo(q.w), bfhi(q.w)} * rstd[u] * w1[j], (f32x4*)(P.out + (size_t)r * D + cc + 4));
                        }
                    }
                }
            }
        } else {
            const int l = (ph - 1) / 9, k = (nrep == 3 && rep == 1) ? 3 : (ph - 1) % 9;
            if ((PHM & 4) && (k == 0 || k == 7)) {
                pg8::Gemm g{xb, k == 0 ? wx + WX_UP / 2 : wy + WY_UP / 2, M, NUP, D, D};
                pg8::StaticOrder S; S.init(M, NUP, G, bid);
                EpiUp E{areg, rstdarr + (size_t)(3 * l + (k == 0 ? 0 : 2)) * M};
                pg8::gemm_phase<EpiUp, pg8::StaticOrder, true, true>(lds, g, S, E, tid);
            } else if ((PHM & 8) && (k == 1 || k == 6 || k == 8)) {
                const bf16_t* A = k == 6 ? (const bf16_t*)(P.ws + WS_MIX) : areg;
                const bf16_t* Bt = k == 1 ? wx + WX_DOWN / 2 : (k == 6 ? wy + WY_OUT / 2 : wy + WY_DOWN / 2);
                const int K = k == 6 ? D : FF;
                const int so = 3 * l + (k == 1 ? 1 : (k == 6 ? 2 : 3));
                const float scale = k == 6 ? 1.f : 0.5f; const int f32out = 0;
                float* part = (float*)(P.ws + (k == 6 ? WS_AREG : WS_MIX));
                {
                    pg8::Gemm g{A, Bt, MP, D, K, K};
                    pg8::StaticOrder S; S.init(MP, D, G, bid);
                    EpiRes E{xb, (float*)(P.ws + WS_D1), rowss + (size_t)so * M * 16, scale, f32out};
                    pg8::gemm_phase<EpiRes, pg8::StaticOrder, false, true>(lds, g, S, E, tid);
                }
                {
                    const int nsl = K >> 8, s = bid >> 2;
                    pg8::Gemm g{A + (size_t)MP * K + s * 256, Bt + s * 256, 256, D, 256, K};
                    SingleOrder S{bid & 3, bid < 4 * nsl};
                    EpiPart E{part + (size_t)s * 256 * D};
                    pg8::gemm_phase<EpiPart, SingleOrder, false, true>(lds, g, S, E, tid);
                    xcd_barrier(xbar);
                    const int r = bid * 8 + wave;
                    if (r < 256) {
                        bf16_t* xr = xb + (size_t)(MP + r) * D; float ss = 0.f;
#pragma unroll
                        for (int j = 0; j < 4; ++j) {
                            const int cc = (lane + 64 * j) * 4;
                            const u32x2 xv = *(const u32x2*)(xr + cc);
                            f32x4 pv[11];
#pragma unroll
                            for (int q = 0; q < 11; ++q) pv[q] = q < nsl ? *(const f32x4*)(part + ((size_t)q * 256 + r) * D + cc) : (f32x4){0.f, 0.f, 0.f, 0.f};
                            f32x4 a = pv[0];
#pragma unroll
                            for (int q = 1; q < 11; ++q) a += pv[q];
                            const f32x4 v = (f32x4){bflo(xv.x), bfhi(xv.x), bflo(xv.y), bfhi(xv.y)} + a * scale;
                            ss += (v.x * v.x + v.y * v.y) + (v.z * v.z + v.w * v.w);
                            if (f32out) *(f32x4*)((float*)(P.ws + WS_D1) + (size_t)(MP + r) * D + cc) = v;
                            else { u32x2 w; w.x = pk2(v.x, v.y); w.y = pk2(v.z, v.w); *(u32x2*)(xr + cc) = w; }
                        }
                        ss = wave_sum(ss);
                        if (lane == 0) rstdarr[(size_t)so * M + MP + r] = rsqrtf(ss * (1.f / 1024.f) + 1e-6f);
                    }
                    {
                        const float* ps = rowss + (size_t)so * M * 16; float* rd = rstdarr + (size_t)so * M;
                        const int gw = bid * 8 + wave, nw = G * 8;
                        for (int r0 = gw * 4; r0 < MP; r0 += nw * 16) {
                            float v[4];
#pragma unroll
                            for (int q = 0; q < 4; ++q) { const int rb = r0 + q * nw * 4; v[q] = rb < MP ? ps[(size_t)rb * 16 + lane] : 0.f; }
#pragma unroll
                            for (int q = 0; q < 4; ++q) {
                                float t = v[q];
                                t += __shfl_xor(t, 1); t += __shfl_xor(t, 2); t += __shfl_xor(t, 4); t += __shfl_xor(t, 8);
                                const int rb = r0 + q * nw * 4;
                                if ((lane & 15) == 0 && rb < MP) rd[rb + (lane >> 4)] = rsqrtf(t * (1.f / 1024.f) + 1e-6f);
                            }
                        }
                    }
                }
            } else if ((PHM & 16) && k == 2) {
                pg8::Gemm g{xb, wx + WX_WIN / 2, M, NINP, D, D};
                pg8::StaticOrder S; S.init(M, NINP, G, bid);
                EpiIn E{areg, (float*)(P.ws + WS_AB), rstdarr + (size_t)(3 * l + 1) * M};
                pg8::gemm_phase<EpiIn, pg8::StaticOrder, true, true>(lds, g, S, E, tid);
            } else if ((PHM & 32) && k == 3) {
                for (int t = bid; t < NTASK; t += G) d1_task(P, l, t, lds, tid, bid);
            } else if ((PHM & 64) && k == 4) {
                if (bid < 144) {
                    int chunk0, nch, h, half; const float* s0 = nullptr; float* sout;
                    if (bid < 16) { const int bh = bid >> 1, b = bh >> 2; half = bid & 1; h = bh & 3; chunk0 = b * 128; nch = 128; sout = P.out + O_PD + (size_t)((l * 2 + b) * 4 + h) * 16384; }
                    else { const int j = (bid - 16) >> 1, sb = j >> 2; half = (bid - 16) & 1; h = j & 3; chunk0 = 256 + sb; nch = 1;
                        s0 = P.in[2] + (size_t)((l * 16 + sb) * 4 + h) * 16384; sout = P.out + O_SD + (size_t)((l * 16 + sb) * 4 + h) * 16384; }
                    d2_seq(P, lds, chunk0, nch, h, half * 64, s0, sout, tid, bid);
                } else {
                    convert_weights(P, l == 0 ? 0 : 1, 1, (bid - 144) * 8 + wave, (G - 144) * 8, (LAS float*)(lds + wave * 16384), lane);
                }
                if (bid >= 16) {
                    __syncthreads();
                    for (int t = bid - 16; t < NPTASK; t += G - 16) pool_task(P, l, t, lds, tid, bid);
                }
            } else if (PHM & 128) {
                for (int t = bid; t < NTASK; t += G) d3_task(P, l, t, lds, tid, bid);
            }
        }
        if (rep + 1 < nrep) xcd_barrier(xbar);
        }
#if PROBE_SYNCS
        if (ph == 0) for (int i = 0; i < PROBE_SYNCS; ++i) xcd_barrier(xbar);
#endif
        if (ph + 1 < P.ph_hi) xcd_barrier(xbar);
    }
}

#ifndef ONE_LAUNCH
#define ONE_LAUNCH 1
#endif
extern "C" void kernel_launch(void* const* d_in, const int* in_sizes, int n_in, void* d_out, int out_size, void* d_ws, size_t ws_size, hipStream_t stream) {
    static int grid = 0;
    if (grid == 0) {
        int dev = 0, cus = 0, per_cu = 0;
        hipGetDevice(&dev);
        hipDeviceGetAttribute(&cus, hipDeviceAttributeMultiprocessorCount, dev);
        hipFuncSetAttribute((const void*)fwd_kernel, hipFuncAttributeMaxDynamicSharedMemorySize, LDS_BYTES);
        hipOccupancyMaxActiveBlocksPerMultiprocessor(&per_cu, (const void*)fwd_kernel, 512, LDS_BYTES);
        (void)hipGetLastError();
        if (per_cu < 1) per_cu = 1;
        grid = cus;
        if (grid < 160) grid = 160;
    }
    Params p{};
    for (int i = 0; i < 23; ++i) p.in[i] = (const float*)d_in[i];
    p.out = (float*)d_out; p.ws = (unsigned char*)d_ws;
#if ONE_LAUNCH
    (void)hipMemsetAsync((unsigned char*)d_ws + WS_BAR, 0, XCD_BAR_WORDS * 4, stream);
    p.ph_lo = 0; p.ph_hi = NPH;
    void* args[] = {&p};
    hipLaunchCooperativeKernel((const void*)fwd_kernel, dim3(grid), dim3(512), args, LDS_BYTES, stream);
#else
    for (int ph = 0; ph < NPH; ++ph) {
        p.ph_lo = ph; p.ph_hi = ph + 1;
        hipLaunchKernelGGL(fwd_kernel, dim3(grid), dim3(512), LDS_BYTES, stream, p);
    }
#endif
}
```

```cpp
#include <hip/hip_runtime.h>
#include <hip/hip_cooperative_groups.h>
namespace cg = cooperative_groups;
namespace pg8 {
#define PG8_LAS __attribute__((address_space(3)))
typedef unsigned short bf16_t;
typedef short bf16x8 __attribute__((ext_vector_type(8)));
typedef float f32x4 __attribute__((ext_vector_type(4)));
typedef unsigned u32x4 __attribute__((ext_vector_type(4)));
constexpr int BM = 256, BK = 64, HALF = 128, HTB = HALF * BK * 2  , STAGE_BYTES = 8 * HTB, NXCD = 8, WGM = 8;

__host__ __device__ __forceinline__ int lds_byte(int r, int c) { const int st = (r >> 4) * 2 + (c >> 5), rr = r & 15, cc = c & 31, ob = rr * 64 + cc * 2; return st * 1024 + (ob ^ (((ob >> 9) & 1) << 5)); }
__host__ __device__ __forceinline__ void stage_rc(int b, int& R, int& C) { const int st = b / 1024, sb = b % 1024, swz = sb ^ (((sb >> 9) & 1) << 5); R = (st >> 1) * 16 + swz / 64; C = (st & 1) * 32 + (swz % 64) / 2; }
__host__ __device__ __forceinline__ int perm32(int rho) { const int n = rho >> 4, i = rho & 15; return 8 * (i >> 2) + 4 * n + (i & 3); }

struct Unit { int pm, pn; };
struct Gemm { const bf16_t* A; const bf16_t* Bt; int M, N, K, ld; };

struct StaticOrder {
    int nM, nN, nwg, G, c;
    __host__ __device__ void init(int M, int N, int G_, int c_) { nM = M / BM; nN = N / BM; nwg = nM * nN; G = G_; c = c_; }
    __host__ __device__ bool next(int i, Unit& u) const {
        const long L = (long)i * G + c; if (L >= nwg) return false;
        int wgid = (int)L; { const int q = nwg / NXCD, r = nwg % NXCD, xcd = wgid % NXCD, off = wgid / NXCD; wgid = (xcd < r ? xcd * (q + 1) : r * (q + 1) + (xcd - r) * q) + off; }
        const int nig = WGM * nN, gid = wgid / nig, fm = gid * WGM, gsz = (nM - fm) < WGM ? (nM - fm) : WGM;
        u.pm = fm + ((wgid % nig) % gsz); u.pn = (wgid % nig) / gsz; return true;
    }
    __device__ __forceinline__ void a_ready(const Unit&) const {}
    __device__ __forceinline__ void done(const Unit&) const {}
};
__device__ __forceinline__ unsigned cvt_pk_bf16(float lo, float hi) { unsigned r; asm volatile("v_cvt_pk_bf16_f32 %0, %1, %2" : "=v"(r) : "v"(lo), "v"(hi)); return r; }
template <class Epi, class Sched, bool ALIGN_EPI = false, bool SP2 = false>
__device__ __forceinline__ void gemm_phase(PG8_LAS unsigned char* lds, const Gemm g, const Sched& S, const Epi& E, int tid0) {
    const int tid = tid0, wid = __builtin_amdgcn_readfirstlane(tid >> 6), lane = tid & 63, wr = wid >> 2, wc = wid & 3, fr = lane & 15, fq = lane >> 4;
    const int K = g.K, nt = K / BK;
    unsigned voffA[2], voffB[2];
#pragma unroll
    for (int i = 0; i < 2; ++i) { int R, C; stage_rc(tid * 16 + i * 8192, R, C); const int Rb = Epi::PERM ? ((R & ~31) + perm32(R & 31)) : R;
        voffA[i] = (unsigned)(R * g.ld + C) * 2u; voffB[i] = (unsigned)(Rb * g.ld + C) * 2u; }
    const size_t kstep = (size_t)(BK * 2);
    const size_t hstep = (size_t)HALF * g.ld * 2;
    const size_t tstep = 2 * hstep;
    const unsigned ldsw = (unsigned)wid * 1024u;
    const int aoff = lds_byte(wr * 64 + fr, fq * 8), boff = lds_byte(wc * 32 + fr, fq * 8);
#define PG8_SA(b, h) (((b) * 2 + (h)) * HTB)
#define PG8_SB(b, h) ((4 + (b) * 2 + (h)) * HTB)
#define PG8_STAGE(bufoff, gbase, voff) do { _Pragma("unroll") for (int _i = 0; _i < 2; ++_i) \
        __builtin_amdgcn_global_load_lds((const unsigned*)((const char*)(gbase) + (voff)[_i]), (PG8_LAS unsigned*)(lds + (bufoff) + ldsw + _i * 8192), 16, 0, 0); } while (0)
#define PG8_LDA(dst, b, h) do { _Pragma("unroll") for (int m = 0; m < 4; ++m) _Pragma("unroll") for (int k = 0; k < 2; ++k) dst[m][k] = *(const PG8_LAS bf16x8*)(lds + PG8_SA(b, h) + aoff + m * 2048 + k * 1024); } while (0)
#define PG8_LDB(dst, b, h) do { _Pragma("unroll") for (int n = 0; n < 2; ++n) _Pragma("unroll") for (int k = 0; k < 2; ++k) dst[n][k] = *(const PG8_LAS bf16x8*)(lds + PG8_SB(b, h) + boff + n * 2048 + k * 1024); } while (0)
#define PG8_MMA(ai, bj, At, Bt) do { __builtin_amdgcn_s_setprio(1); _Pragma("unroll") for (int m = 0; m < 4; ++m) _Pragma("unroll") for (int n = 0; n < 2; ++n) _Pragma("unroll") for (int k = 0; k < 2; ++k) \
        acc[ai][bj][m][n] = __builtin_amdgcn_mfma_f32_16x16x32_bf16(Bt[n][k], At[m][k], acc[ai][bj][m][n], 0, 0, 0); __builtin_amdgcn_s_setprio(0); } while (0)
#define PG8_WAIT_V(n) asm volatile("s_waitcnt vmcnt(" #n ")" ::: "memory")
#define PG8_WAIT_L(n) asm volatile("s_waitcnt lgkmcnt(" #n ")" ::: "memory")
#define PG8_BAR __builtin_amdgcn_s_barrier()
#define PG8_SCHED __builtin_amdgcn_sched_barrier(0)
    Unit cur, nxt; int ui = 0;
    if (!S.next(0, cur)) return;
    f32x4 acc[2][2][4][2];
#pragma unroll
    for (int a = 0; a < 2; ++a)
#pragma unroll
        for (int b = 0; b < 2; ++b)
#pragma unroll
            for (int m = 0; m < 4; ++m)
#pragma unroll
                for (int n = 0; n < 2; ++n) acc[a][b][m][n] = (f32x4){0.f, 0.f, 0.f, 0.f};
    bf16x8 At[4][2], B0[2][2], B1[2][2];
    const char* cA = (const char*)g.A + (size_t)cur.pm * tstep; const char* cB = (const char*)g.Bt + (size_t)cur.pn * tstep;
    S.a_ready(cur);
    if constexpr (SP2) {
        PG8_STAGE(PG8_SB(0, 0), cB, voffB); PG8_STAGE(PG8_SB(0, 1), cB + hstep, voffB); PG8_STAGE(PG8_SA(0, 0), cA, voffA); PG8_STAGE(PG8_SA(0, 1), cA + hstep, voffA);
        if (wr == 1) PG8_BAR;
        PG8_WAIT_V(2); PG8_BAR;
        PG8_STAGE(PG8_SB(1, 0), cB + kstep, voffB); PG8_STAGE(PG8_SA(1, 0), cA + kstep, voffA); PG8_STAGE(PG8_SB(1, 1), cB + hstep + kstep, voffB);
        PG8_WAIT_V(6); PG8_BAR;
    } else {
        PG8_STAGE(PG8_SB(0, 0), cB, voffB); PG8_STAGE(PG8_SA(0, 0), cA, voffA); PG8_STAGE(PG8_SB(0, 1), cB + hstep, voffB); PG8_STAGE(PG8_SA(0, 1), cA + hstep, voffA);
        if (wr == 1) PG8_BAR;
        PG8_WAIT_V(4); PG8_BAR;
        PG8_STAGE(PG8_SB(1, 0), cB + kstep, voffB); PG8_STAGE(PG8_SA(1, 0), cA + kstep, voffA); PG8_STAGE(PG8_SB(1, 1), cB + hstep + kstep, voffB);
        PG8_WAIT_V(6); PG8_BAR;
    }
    for (;;) {
        const bool has_next = S.next(ui + 1, nxt);
        const char* nA = has_next ? (const char*)g.A + (size_t)nxt.pm * tstep : cA; const char* nB = has_next ? (const char*)g.Bt + (size_t)nxt.pn * tstep : cB;
        for (int t = 0; t < nt; t += 2) {
            const bool last = (t == nt - 2);
            const char* a1 = cA + (size_t)(t + 1) * kstep;
            const char* a2 = last ? nA : cA + (size_t)(t + 2) * kstep; const char* b2 = last ? nB : cB + (size_t)(t + 2) * kstep;
            const char* a3 = a2 + kstep; const char* b3 = b2 + kstep;
            if (last && has_next) S.a_ready(nxt);
            if constexpr (SP2) {
            PG8_LDB(B0, 0, 0); PG8_LDB(B1, 0, 1); PG8_SCHED; PG8_LDA(At, 0, 0); PG8_STAGE(PG8_SA(1, 1), a1 + hstep, voffA);
            PG8_WAIT_V(8); PG8_WAIT_L(0); PG8_BAR; PG8_MMA(0, 0, At, B0); PG8_MMA(0, 1, At, B1); PG8_BAR; PG8_SCHED;
            PG8_LDA(At, 0, 1); PG8_STAGE(PG8_SB(0, 0), b2, voffB); PG8_STAGE(PG8_SB(0, 1), b2 + hstep, voffB); PG8_STAGE(PG8_SA(0, 0), a2, voffA);
            PG8_WAIT_V(8); PG8_WAIT_L(0); PG8_BAR; PG8_MMA(1, 0, At, B0); PG8_MMA(1, 1, At, B1); PG8_BAR; PG8_SCHED;
            PG8_LDB(B0, 1, 0); PG8_LDB(B1, 1, 1); PG8_SCHED; PG8_LDA(At, 1, 0); PG8_STAGE(PG8_SA(0, 1), a2 + hstep, voffA);
            PG8_WAIT_V(8); PG8_WAIT_L(0); PG8_BAR; PG8_MMA(0, 0, At, B0); PG8_MMA(0, 1, At, B1); PG8_BAR; PG8_SCHED;
            PG8_LDA(At, 1, 1); PG8_STAGE(PG8_SB(1, 0), b3, voffB); PG8_STAGE(PG8_SB(1, 1), b3 + hstep, voffB); PG8_STAGE(PG8_SA(1, 0), a3, voffA);
            PG8_WAIT_V(8); PG8_WAIT_L(0); PG8_BAR; PG8_MMA(1, 0, At, B0); PG8_MMA(1, 1, At, B1); PG8_BAR; PG8_SCHED;
            } else {
            PG8_LDB(B0, 0, 0); PG8_SCHED; PG8_LDA(At, 0, 0); PG8_STAGE(PG8_SA(1, 1), a1 + hstep, voffA);
            PG8_WAIT_L(8); PG8_BAR; PG8_WAIT_L(0); PG8_MMA(0, 0, At, B0); PG8_BAR; PG8_SCHED;
            PG8_LDB(B1, 0, 1); PG8_STAGE(PG8_SB(0, 0), b2, voffB);
            PG8_BAR; PG8_WAIT_L(0); PG8_MMA(0, 1, At, B1); PG8_BAR;
            PG8_LDA(At, 0, 1); PG8_STAGE(PG8_SA(0, 0), a2, voffA);
            PG8_BAR; PG8_WAIT_L(0); PG8_MMA(1, 0, At, B0); PG8_BAR; PG8_SCHED;
            PG8_STAGE(PG8_SB(0, 1), b2 + hstep, voffB);
            PG8_WAIT_V(6); PG8_BAR; PG8_MMA(1, 1, At, B1); PG8_BAR;
            PG8_LDB(B0, 1, 0); PG8_SCHED; PG8_LDA(At, 1, 0); PG8_STAGE(PG8_SA(0, 1), a2 + hstep, voffA);
            PG8_WAIT_L(8); PG8_BAR; PG8_WAIT_L(0); PG8_MMA(0, 0, At, B0); PG8_BAR; PG8_SCHED;
            PG8_LDB(B1, 1, 1); PG8_STAGE(PG8_SB(1, 0), b3, voffB);
            PG8_BAR; PG8_WAIT_L(0); PG8_MMA(0, 1, At, B1); PG8_BAR;
            PG8_LDA(At, 1, 1); PG8_STAGE(PG8_SA(1, 0), a3, voffA);
            PG8_BAR; PG8_WAIT_L(0); PG8_MMA(1, 0, At, B0); PG8_BAR; PG8_SCHED;
            PG8_STAGE(PG8_SB(1, 1), b3 + hstep, voffB);
            PG8_WAIT_V(6); PG8_BAR; PG8_MMA(1, 1, At, B1); PG8_BAR;
            }
        }
        if constexpr (ALIGN_EPI) { if (wr == 0) PG8_BAR; }
        if constexpr (!Epi::AFTER_DRAIN) { E(acc, cur, wr, wc, fr, fq); S.done(cur); }
        if (!has_next) break;
#pragma unroll
        for (int a = 0; a < 2; ++a)
#pragma unroll
            for (int b = 0; b < 2; ++b)
#pragma unroll
                for (int m = 0; m < 4; ++m)
#pragma unroll
                    for (int n = 0; n < 2; ++n) acc[a][b][m][n] = (f32x4){0.f, 0.f, 0.f, 0.f};
        cur = nxt; cA = nA; cB = nB; ++ui;
        if constexpr (ALIGN_EPI) { if (wr == 1) PG8_BAR; }
    }
    PG8_WAIT_V(0);
    if constexpr (!ALIGN_EPI) { if (wr == 0) PG8_BAR; }
    PG8_BAR;
    if constexpr (Epi::AFTER_DRAIN) { E.fused(acc, cur, wr, wc, fr, fq, lds, wid, lane); S.done(cur); }
#undef PG8_SA
#undef PG8_SB
#undef PG8_STAGE
#undef PG8_LDA
#undef PG8_LDB
#undef PG8_MMA
#undef PG8_WAIT_V
#undef PG8_WAIT_L
#undef PG8_BAR
#undef PG8_SCHED
}
}

#define LAS __attribute__((address_space(3)))
using pg8::bf16_t; using pg8::bf16x8; using pg8::f32x4; using pg8::u32x4;
typedef unsigned u32x2 __attribute__((ext_vector_type(2)));

constexpr int D = 1024, FF = 2816, NUP = 5632, NINP = 2816, PW = 2560;
constexpr int MP = 16384, M = 16640, SEQ = 8192;
constexpr int NTASK = 1088, NPTASK = 1088;
constexpr float EPS = 1e-6f;
constexpr int NPH = 20;
#ifndef PHM
#define PHM 255
#endif
#ifndef PROBE_REP
#define PROBE_REP 0
#endif
#ifndef PROBE_SYNCS
#define PROBE_SYNCS 0
#endif
constexpr int LDS_BYTES = 148480;
constexpr int LDS_BARW = 147968;

constexpr size_t WS_AREG = 0;
constexpr size_t WS_XB   = 93716480;
constexpr size_t WS_MIX  = 127795200;
constexpr size_t WS_D1   = 161873920;
constexpr size_t WS_WX   = 233177088;
constexpr size_t WS_ROWSS= 256245760;
constexpr size_t WS_AB   = 263700480;
constexpr size_t WS_GL   = 264232960;
constexpr size_t WS_WPT  = 264237312;
constexpr size_t WS_BAR  = 264499456;
constexpr size_t WS_RSTD = 264513280;
constexpr size_t WX_UP = 0, WX_DOWN = 11534336, WX_WIN = 17301504;
constexpr size_t DO_SNT = 0;
constexpr size_t DO_QK  = 35651584;
constexpr size_t DO_WY  = 44564480;
constexpr size_t WY_OUT = 0, WY_UP = 2097152, WY_DOWN = 13631488;
constexpr size_t O_PD = 17039360, O_PC = 17301504, O_PP = 17319936, O_SD = 17350656, O_SC = 19447808, O_SP = 19595264;

struct Params { const float* in[23]; float* out; unsigned char* ws; int ph_lo, ph_hi; };

__device__ __forceinline__ float bf2f(bf16_t v) { return __uint_as_float(((unsigned)v) << 16); }
__device__ __forceinline__ float bflo(unsigned u) { return __uint_as_float(u << 16); }
__device__ __forceinline__ float bfhi(unsigned u) { return __uint_as_float(u & 0xffff0000u); }
__device__ __forceinline__ unsigned pk2(float lo, float hi) {
    typedef float f2 __attribute__((ext_vector_type(2))); typedef __bf16 b2 __attribute__((ext_vector_type(2)));
    f2 v = {lo, hi}; b2 b = __builtin_convertvector(v, b2); return __builtin_bit_cast(unsigned, b);
}
__device__ __forceinline__ bf16_t f2bf(float x) { return (bf16_t)(pk2(x, 0.f) & 0xffffu); }
__device__ __forceinline__ float row_rstd(const float* part, int r) {
    const f32x4* q = (const f32x4*)(part + (size_t)r * 16);
    const f32x4 a = q[0], b = q[1], c = q[2], d = q[3];
    const float s = ((a.x + a.y) + (a.z + a.w)) + ((b.x + b.y) + (b.z + b.w)) + ((c.x + c.y) + (c.z + c.w)) + ((d.x + d.y) + (d.z + d.w));
    return rsqrtf(s * (1.f / 1024.f) + 1e-6f);
}
__device__ __forceinline__ float silu_f(float x) { return x * __builtin_amdgcn_rcpf(1.f + __expf(-x)); }
__device__ __forceinline__ float wave_sum(float v) {
#pragma unroll
    for (int o = 1; o < 64; o <<= 1) v += __shfl_xor(v, o);
    return v;
}
__device__ __forceinline__ float red16(float v) {
    v += __builtin_bit_cast(float, __builtin_amdgcn_update_dpp(0, __builtin_bit_cast(int, v), 0xB1, 0xF, 0xF, true));
    v += __builtin_bit_cast(float, __builtin_amdgcn_update_dpp(0, __builtin_bit_cast(int, v), 0x4E, 0xF, 0xF, true));
    v += __builtin_bit_cast(float, __builtin_amdgcn_update_dpp(0, __builtin_bit_cast(int, v), 0x141, 0xF, 0xF, true));
    v += __builtin_bit_cast(float, __builtin_amdgcn_update_dpp(0, __builtin_bit_cast(int, v), 0x140, 0xF, 0xF, true));
    return v;
}
#define LDS_WAIT() asm volatile("s_waitcnt lgkmcnt(0)" ::: "memory")
#define MFMA16(a, b, c) __builtin_amdgcn_mfma_f32_16x16x32_bf16((a), (b), (c), 0, 0, 0)


#define XB_TMO      128
#define XB_XCNT(j)  (256  + 64 * (j))
#define XB_XSUB(j)  (1280 + 64 * (j))
#define XB_XGEN(j)  (2304 + 64 * (j))
#define XB_TOP      3328
#define XB_TOPGEN   3392
#define XCD_BAR_WORDS 3456
#define XB_SPIN_CAP (1u << 20)
__device__ __forceinline__ unsigned xb_ld(unsigned* p)              { return __hip_atomic_load(p, __ATOMIC_RELAXED, __HIP_MEMORY_SCOPE_AGENT); }
__device__ __forceinline__ unsigned xb_add(unsigned* p, unsigned v) { return __hip_atomic_fetch_add(p, v, __ATOMIC_RELAXED, __HIP_MEMORY_SCOPE_AGENT); }
__device__ __forceinline__ unsigned xb_xcc_id() { return (unsigned)__builtin_amdgcn_s_getreg((3 << 11) | 20) & 0xFu; }
#define XB_SPIN(cond, bar) do { unsigned _sp = 0; while (cond) { __builtin_amdgcn_s_sleep(1); \
    if ((++_sp & 255u) == 0u) { if (xb_ld(&(bar)[XB_TMO])) break; if (_sp > XB_SPIN_CAP) { atomicAdd(&(bar)[XB_TMO], 1u); break; } } } } while (0)
struct XcdBarrier { unsigned* bar; unsigned x; volatile LAS unsigned* st; };
__device__ __forceinline__ XcdBarrier xcd_barrier_post(unsigned* bar, volatile LAS unsigned* st) {
    XcdBarrier b; b.bar = bar; b.x = xb_xcc_id(); b.st = st;
    if (threadIdx.x == 0) (void)xb_add(&bar[XB_XCNT(b.x)], 1u);
    return b;
}
__device__ __forceinline__ void xcd_barrier_complete(unsigned* bar, unsigned x, unsigned& nloc, unsigned& nx) {
    const unsigned G = gridDim.x * gridDim.y * gridDim.z;
    unsigned sum, cnt, mine, sp = 0u;
    for (;;) {
        sum = 0u; cnt = 0u; mine = 0u;
#pragma unroll
        for (unsigned j = 0; j < 16; ++j) { const unsigned c = xb_ld(&bar[XB_XCNT(j)]); sum += c; cnt += (c > 0u) ? 1u : 0u; mine = (j == x) ? c : mine; }
        if (sum == G) break;
        __builtin_amdgcn_s_sleep(1);
        if ((++sp & 255u) == 0u) { if (xb_ld(&bar[XB_TMO])) break; if (sp > XB_SPIN_CAP) { atomicAdd(&bar[XB_TMO], 1u); break; } }
    }
    nloc = mine > 0u ? mine : 1u; nx = cnt > 0u ? cnt : 1u;
}
__device__ __forceinline__ void xcd_barrier(const XcdBarrier& b) {
    asm volatile("s_waitcnt vmcnt(0)" ::: "memory");
    __syncthreads();
    if (threadIdx.x == 0) {
        unsigned* bar = b.bar;
        __builtin_amdgcn_s_waitcnt(0);
        unsigned nloc = b.st[0], nx = b.st[1];
        if (nloc == 0u) { xcd_barrier_complete(bar, b.x, nloc, nx); b.st[0] = nloc; b.st[1] = nx; }
        const unsigned old = xb_add(&bar[XB_XSUB(b.x)], 1u);
        const unsigned gen = old / nloc;
        if (old + 1u == (gen + 1u) * nloc) {
            __builtin_amdgcn_fence(__ATOMIC_RELEASE, "agent");
            asm volatile("s_waitcnt vmcnt(0)" ::: "memory");
            const unsigned og = xb_add(&bar[XB_TOP], 1u);
            const unsigned tg = og / nx;
            if (og + 1u == (tg + 1u) * nx) xb_add(&bar[XB_TOPGEN], 1u);
            else XB_SPIN(xb_ld(&bar[XB_TOPGEN]) == tg, bar);
            __builtin_amdgcn_fence(__ATOMIC_ACQUIRE, "agent");
            xb_add(&bar[XB_XGEN(b.x)], 1u);
            asm volatile("s_waitcnt vmcnt(0)" ::: "memory");
        } else {
            XB_SPIN(xb_ld(&bar[XB_XGEN(b.x)]) == gen, bar);
            __builtin_amdgcn_fence(__ATOMIC_ACQUIRE, "agent");
            asm volatile("s_waitcnt vmcnt(0)" ::: "memory");
        }
    }
    __syncthreads();
}

struct EpiUp {
    static constexpr bool PERM = true, AFTER_DRAIN = false;
    bf16_t* act; const float* rstd;
    __device__ __forceinline__ void operator()(const f32x4 (&acc)[2][2][4][2], const pg8::Unit& u, int wr, int wc, int fr, int fq) const {
        const int row0 = u.pm * 256 + wr * 64 + fr, col0 = u.pn * 128 + wc * 32 + 8 * fq;
        float rs8[8];
#pragma unroll
        for (int q = 0; q < 8; ++q) rs8[q] = this->rstd[row0 + (q >> 2) * 128 + (q & 3) * 16];
#pragma unroll
        for (int ai = 0; ai < 2; ++ai)
#pragma unroll
            for (int m = 0; m < 4; ++m) {
                const int r = row0 + ai * 128 + m * 16;
                const float rstd = rs8[ai * 4 + m];
                float o[8];
#pragma unroll
                for (int n = 0; n < 2; ++n) {
                    const f32x4 ga = acc[ai][0][m][n], ua = acc[ai][1][m][n];
                    const f32x4 e4 = ga * (rstd * -1.4426950408889634f);
                    const f32x4 gu = ga * ua * (rstd * rstd);
#pragma unroll
                    for (int j = 0; j < 4; ++j) o[n * 4 + j] = gu[j] * __builtin_amdgcn_rcpf(1.f + __builtin_amdgcn_exp2f(e4[j]));
                }
                u32x4 w; w.x = pk2(o[0], o[1]); w.y = pk2(o[2], o[3]); w.z = pk2(o[4], o[5]); w.w = pk2(o[6], o[7]);
                *(u32x4*)(act + (size_t)r * FF + col0) = w;
            }
    }
};
struct EpiRes {
    static constexpr bool PERM = true, AFTER_DRAIN = false;
    bf16_t* xb; float* xf; float* rowss_out; float scale; int f32out;
    __device__ __forceinline__ void operator()(const f32x4 (&acc)[2][2][4][2], const pg8::Unit& u, int wr, int wc, int fr, int fq) const {
        const int row0 = u.pm * 256 + wr * 64 + fr, col0 = u.pn * 256 + wc * 32 + 8 * fq;
#pragma unroll
        for (int ai = 0; ai < 2; ++ai) {
        u32x4 xv[2][4][2];
#pragma unroll
            for (int m = 0; m < 4; ++m)
#pragma unroll
                for (int bj = 0; bj < 2; ++bj) xv[ai][m][bj] = *(const u32x4*)(xb + (size_t)(row0 + ai * 128 + m * 16) * D + col0 + bj * 128);
#pragma unroll
            for (int m = 0; m < 4; ++m) {
                const int r = row0 + ai * 128 + m * 16;
                float ss = 0.f;
#pragma unroll
                for (int bj = 0; bj < 2; ++bj) {
                    bf16_t* xp = xb + (size_t)r * D + col0 + bj * 128;
                    const u32x4 q = xv[ai][m][bj];
                    float v[8];
                    v[0] = bflo(q.x); v[1] = bfhi(q.x); v[2] = bflo(q.y); v[3] = bfhi(q.y); v[4] = bflo(q.z); v[5] = bfhi(q.z); v[6] = bflo(q.w); v[7] = bfhi(q.w);
#pragma unroll
                    for (int n = 0; n < 2; ++n)
#pragma unroll
                        for (int j = 0; j < 4; ++j) { v[n * 4 + j] += scale * acc[ai][bj][m][n][j]; ss += v[n * 4 + j] * v[n * 4 + j]; }
                    if (f32out) {
                        float* fp = xf + (size_t)r * D + col0 + bj * 128;
                        *(f32x4*)fp = (f32x4){v[0], v[1], v[2], v[3]}; *(f32x4*)(fp + 4) = (f32x4){v[4], v[5], v[6], v[7]};
                    } else {
                        u32x4 w; w.x = pk2(v[0], v[1]); w.y = pk2(v[2], v[3]); w.z = pk2(v[4], v[5]); w.w = pk2(v[6], v[7]);
                        *(u32x4*)xp = w;
                    }
                }
                ss += __shfl_xor(ss, 16); ss += __shfl_xor(ss, 32);
                if (fq == 0) rowss_out[(size_t)r * 16 + u.pn * 4 + wc] = ss;
            }
        }
    }
};
struct SingleOrder {
    int pn; bool have;
    __device__ bool next(int i, pg8::Unit& u) const { if (i != 0 || !have) return false; u.pm = 0; u.pn = pn; return true; }
    __device__ __forceinline__ void a_ready(const pg8::Unit&) const {}
    __device__ __forceinline__ void done(const pg8::Unit&) const {}
};
struct EpiPart {
    static constexpr bool PERM = true, AFTER_DRAIN = false;
    float* part;
    __device__ __forceinline__ void operator()(const f32x4 (&acc)[2][2][4][2], const pg8::Unit& u, int wr, int wc, int fr, int fq) const {
        const int row0 = wr * 64 + fr, col0 = u.pn * 256 + wc * 32 + 8 * fq;
#pragma unroll
        for (int ai = 0; ai < 2; ++ai)
#pragma unroll
            for (int m = 0; m < 4; ++m)
#pragma unroll
                for (int bj = 0; bj < 2; ++bj) {
                    float* fp = part + (size_t)(row0 + ai * 128 + m * 16) * D + col0 + bj * 128;
                    *(f32x4*)fp = acc[ai][bj][m][0]; *(f32x4*)(fp + 4) = acc[ai][bj][m][1];
                }
    }
};
struct EpiIn {
    static constexpr bool PERM = true, AFTER_DRAIN = false;
    bf16_t* p; float* ab; const float* rstd;
    __device__ __forceinline__ void operator()(const f32x4 (&acc)[2][2][4][2], const pg8::Unit& u, int wr, int wc, int fr, int fq) const {
        const int row0 = u.pm * 256 + wr * 64 + fr, col0 = u.pn * 256 + wc * 32 + 8 * fq;
        float rs8[8];
#pragma unroll
        for (int q = 0; q < 8; ++q) rs8[q] = this->rstd[row0 + (q >> 2) * 128 + (q & 3) * 16];
#pragma unroll
        for (int ai = 0; ai < 2; ++ai)
#pragma unroll
            for (int m = 0; m < 4; ++m) {
                const int r = row0 + ai * 128 + m * 16;
                const float rstd = rs8[ai * 4 + m];
                if (u.pn < 10) {
#pragma unroll
                    for (int bj = 0; bj < 2; ++bj) {
                        const f32x4 a0 = acc[ai][bj][m][0] * rstd, a1 = acc[ai][bj][m][1] * rstd;
                        u32x4 w; w.x = pk2(a0[0], a0[1]); w.y = pk2(a0[2], a0[3]); w.z = pk2(a1[0], a1[1]); w.w = pk2(a1[2], a1[3]);
                        *(u32x4*)(p + (size_t)r * PW + col0 + bj * 128) = w;
                    }
                } else if (wc == 0 && fq == 0) {
                    *(f32x4*)(ab + (size_t)r * 8) = acc[ai][0][m][0] * rstd; *(f32x4*)(ab + (size_t)r * 8 + 4) = acc[ai][0][m][1] * rstd;
                }
            }
    }
};

__device__ __forceinline__ int map_row(int n, int mode) {
    if (mode == 1) return ((n >> 7) << 8) + (n & 127);
    if (mode == 2) return ((n >> 7) << 8) + 128 + (n & 127);
    if (mode == 3) return n < 2048 ? n : (n < 2056 ? 2560 + (n - 2048) : n - 8);
    return n;
}
__device__ __forceinline__ void tr_item(const float* W, int N, int K, bf16_t* WT, int item, int mode, const float* kscale, LAS float* scr, int lane) {
    const int nnb = (N + 31) >> 5, kb = item / nnb, nb = item - kb * nnb, k0 = kb * 64, n0 = nb * 32;
    const int nsrc = min(n0 + (lane & 31), N - 1);
    const float* wp = W + (size_t)(k0 + (lane >> 5)) * N + nsrc;
#pragma unroll
    for (int i0 = 0; i0 < 32; i0 += 16) {
        float v[16];
#pragma unroll
        for (int i = 0; i < 16; ++i) v[i] = __builtin_nontemporal_load(wp + (size_t)(2 * (i0 + i)) * N);
        if (kscale) {
#pragma unroll
            for (int i = 0; i < 16; ++i) v[i] *= kscale[k0 + 2 * (i0 + i) + (lane >> 5)];
        }
#pragma unroll
        for (int i = 0; i < 16; ++i) scr[(2 * (i0 + i) + (lane >> 5)) * 33 + (lane & 31)] = v[i];
    }
    LDS_WAIT();
    const int c = lane & 7;
#pragma unroll
    for (int j = 0; j < 4; ++j) {
        const int nl = (lane >> 3) + 8 * j, n = n0 + nl;
        const LAS float* s = scr + (8 * c) * 33 + nl;
        u32x4 o; o.x = pk2(s[0 * 33], s[1 * 33]); o.y = pk2(s[2 * 33], s[3 * 33]); o.z = pk2(s[4 * 33], s[5 * 33]); o.w = pk2(s[6 * 33], s[7 * 33]);
        if (n < N) *(u32x4*)(WT + (size_t)map_row(n, mode) * K + k0 + 8 * c) = o;
    }
    LDS_WAIT();
}
__device__ __forceinline__ void convert_weights(const Params& P, int set, int l, int widx, int nw, LAS float* scr, int lane) {
    constexpr int I_G = 16 * 88, I_D = 44 * 32, I_W = 16 * 81, I_O = 16 * 32;
    bf16_t* wx = (bf16_t*)(P.ws + WS_WX); bf16_t* wy = (bf16_t*)((unsigned char*)P.out + DO_WY);
    if (set == 0) {
        const float* nf = P.in[5] + l * D; const float* nm = P.in[9] + l * D;
        const float* wg = P.in[6] + (size_t)l * D * FF; const float* wu = P.in[7] + (size_t)l * D * FF; const float* wd = P.in[8] + (size_t)l * FF * D; const float* wi = P.in[10] + (size_t)l * D * 2568;
        for (int it = widx; it < 2 * I_G + I_D + I_W; it += nw) {
            int r = it;
            if (r < I_G) { tr_item(wg, FF, D, wx + WX_UP / 2, r, 1, nf, scr, lane); continue; } r -= I_G;
            if (r < I_G) { tr_item(wu, FF, D, wx + WX_UP / 2, r, 2, nf, scr, lane); continue; } r -= I_G;
            if (r < I_D) { tr_item(wd, D, FF, wx + WX_DOWN / 2, r, 0, nullptr, scr, lane); continue; } r -= I_D;
            tr_item(wi, 2568, D, wx + WX_WIN / 2, r, 3, nm, scr, lane);
        }
    } else {
        const float* nf = P.in[18] + l * D;
        const float* wo = P.in[17] + (size_t)l * D * D; const float* wg = P.in[19] + (size_t)l * D * FF; const float* wu = P.in[20] + (size_t)l * D * FF; const float* wd = P.in[21] + (size_t)l * FF * D;
        for (int it = widx; it < I_O + 2 * I_G + I_D; it += nw) {
            int r = it;
            if (r < I_O) { tr_item(wo, D, D, wy + WY_OUT / 2, r, 0, nullptr, scr, lane); continue; } r -= I_O;
            if (r < I_G) { tr_item(wg, FF, D, wy + WY_UP / 2, r, 1, nf, scr, lane); continue; } r -= I_G;
            if (r < I_G) { tr_item(wu, FF, D, wy + WY_UP / 2, r, 2, nf, scr, lane); continue; } r -= I_G;
            tr_item(wd, D, FF, wy + WY_DOWN / 2, r, 0, nullptr, scr, lane);
        }
    }
}

__device__ __forceinline__ void phase0(const Params& P, LAS unsigned char* lds, int tid0, int bid0) {
    const int tid = tid0, lane = tid & 63, wave = tid >> 6;
    const int gw = bid0 * 8 + wave, NGW = gridDim.x * 8;
    float* rowss = (float*)(P.ws + WS_ROWSS);
    bf16_t* xb = (bf16_t*)(P.ws + WS_XB);
    for (int r0 = gw; r0 < M; r0 += 4 * NGW) {
        f32x4 v[4][4];
#pragma unroll
        for (int u = 0; u < 4; ++u) {
            const int r = min(r0 + u * NGW, M - 1);
            const float* src = r < MP ? P.in[0] + (size_t)r * D : P.in[1] + (size_t)(r - MP) * D;
            const f32x4* xr = (const f32x4*)src + lane;
#pragma unroll
            for (int j = 0; j < 4; ++j) v[u][j] = __builtin_nontemporal_load(xr + 64 * j);
        }
#pragma unroll
        for (int u = 0; u < 4; ++u) {
            const int r = r0 + u * NGW;
            if (r < M) {
                float s = 0.f;
#pragma unroll
                for (int j = 0; j < 4; ++j) s += (v[u][j].x * v[u][j].x + v[u][j].y * v[u][j].y) + (v[u][j].z * v[u][j].z + v[u][j].w * v[u][j].w);
                s = wave_sum(s);
                if (lane == 0) ((float*)(P.ws + WS_RSTD))[r] = rsqrtf(s * (1.f / 1024.f) + 1e-6f);
                u32x2* o8 = (u32x2*)(xb + (size_t)r * D) + lane;
#pragma unroll
                for (int j = 0; j < 4; ++j) { u32x2 w; w.x = pk2(v[u][j].x, v[u][j].y); w.y = pk2(v[u][j].z, v[u][j].w); o8[64 * j] = w; }
            }
        }
    }
    LAS float* scr = (LAS float*)(lds + wave * 16384);
    convert_weights(P, 0, 0, gw, NGW, scr, lane);
    convert_weights(P, 1, 0, gw, NGW, scr, lane);
    bf16_t* wpt = (bf16_t*)(P.ws + WS_WPT);
    for (int it = gw; it < 64; it += NGW) { const int mat = it >> 3; tr_item(P.in[15] + mat * 16384, 128, 128, wpt + mat * 16384, it & 7, 0, nullptr, scr, lane); }
}

__device__ __forceinline__ void d1_task(const Params& P, int l, int task, LAS unsigned char* lds, int tid0, int bid0) {
    int tidl = tid0; asm volatile("" : "+v"(tidl));
    const int tid = tidl, lane = tid & 63, wave = tid >> 6;
    const int c = task >> 2, h = task & 3;
    const bool samp = c >= 256; const int sb = c - 256;
    const int row0 = samp ? MP + sb * 16 : c * 64, nvalid = samp ? 16 : 64;
    const int bq = c >> 7, nq = c & 127;
    LAS float* sV = (LAS float*)lds;
    LAS bf16_t* sK = (LAS bf16_t*)(lds + 32768);
    LAS bf16_t* sQ = (LAS bf16_t*)(lds + 50176);
    LAS float* sGc = (LAS float*)(lds + 67584);
    LAS float* sBeta = sGc + 64; LAS float* sEg = sGc + 128; LAS float* sGl = sGc + 192;
    LAS float* sCW = (LAS float*)(lds + 68608);
    LAS bf16_t* sRaw = (LAS bf16_t*)(lds + 74752);
    LAS float* sAT = (LAS float*)(lds + 74752);
    const bf16_t* p = (const bf16_t*)(P.ws + WS_AREG);
    const float* ab = (const float*)(P.ws + WS_AB);
    const float* convw = P.in[11] + (size_t)l * 4 * 1536;
    const float* sconv = P.in[3] + (size_t)(l * 16 + (samp ? sb : 0)) * 3 * 1536;
    bf16_t* d1 = (bf16_t*)(P.ws + WS_D1) + (size_t)task * 32768;
    bf16_t* qkb = (bf16_t*)((unsigned char*)P.out + DO_QK) + (size_t)task * 4096;
    {
        u32x4 st[7];
#pragma unroll
        for (int q = 0; q < 7; ++q) {
            const int idx = q * 512 + tid;
            u32x4 v = (u32x4){0u, 0u, 0u, 0u};
            if (idx < 67 * 48) {
                const int rrow = idx / 48, pc = idx - rrow * 48, col = (pc >> 4) * 512 + h * 128 + (pc & 15) * 8, rel = rrow - 3;
                if (!samp) {
                    const int pos = nq * 64 + rel;
                    if (pos >= 0) v = __builtin_nontemporal_load((const u32x4*)(p + (size_t)(bq * SEQ + pos) * PW + col));
                } else if (rel < 0) {
                    const float* sp = sconv + (3 + rel) * 1536 + col;
                    const f32x4 q0 = *(const f32x4*)sp, q1 = *(const f32x4*)(sp + 4);
                    v.x = pk2(q0.x, q0.y); v.y = pk2(q0.z, q0.w); v.z = pk2(q1.x, q1.y); v.w = pk2(q1.z, q1.w);
                } else if (rel < 16) v = *(const u32x4*)(p + (size_t)(row0 + rel) * PW + col);
            }
            st[q] = v;
        }
        f32x4 cw = (f32x4){0.f, 0.f, 0.f, 0.f};
        if (tid < 384) { const int tap = tid / 96, c4 = tid - tap * 96; cw = *(const f32x4*)(convw + tap * 1536 + (c4 / 32) * 512 + h * 128 + (c4 & 31) * 4); }
#pragma unroll
        for (int q = 0; q < 7; ++q) { const int idx = q * 512 + tid; if (idx < 67 * 48) *(LAS u32x4*)(sRaw + idx * 8) = st[q]; }
        if (tid < 384) *(LAS f32x4*)(sCW + tid * 4) = cw;
    }
    if (tid < 64) {
        const int j = tid; float beta = 0.f, gv = 0.f;
        if (j < nvalid) {
            const float a = ab[(size_t)(row0 + j) * 8 + h], bb = ab[(size_t)(row0 + j) * 8 + 4 + h];
            beta = 1.f / (1.f + __expf(-bb));
            const float x = a + P.in[13][l * 4 + h];
            const float sp = x > 20.f ? x : log1pf(__expf(x));
            gv = -__expf(P.in[12][l * 4 + h]) * sp;
        }
#pragma unroll
        for (int o = 1; o < 64; o <<= 1) { const float t = __shfl_up(gv, o); if (lane >= o) gv += t; }
        sGc[j] = gv; sBeta[j] = beta; sEg[j] = __expf(gv);
        if (j == 63) { sGl[0] = gv; ((float*)(P.ws + WS_GL))[task] = __expf(gv); }
    }
    __syncthreads();
    {
        const int rr = tid >> 4, l16 = tid & 15;
#pragma unroll 1
        for (int pass = 0; pass < 2; ++pass) {
            const int i = rr + 32 * pass;
            const bool valid = i < nvalid;
#pragma unroll
            for (int t = 0; t < 3; ++t) {
                float a8[8];
#pragma unroll
                for (int e = 0; e < 8; ++e) a8[e] = 0.f;
                if (valid) {
#pragma unroll
                    for (int tap = 0; tap < 4; ++tap) {
                        const u32x4 q = *(const LAS u32x4*)(sRaw + (i + tap) * 384 + t * 128 + l16 * 8);
                        const f32x4 w0 = *(const LAS f32x4*)(sCW + tap * 384 + t * 128 + l16 * 8), w1 = *(const LAS f32x4*)(sCW + tap * 384 + t * 128 + l16 * 8 + 4);
                        a8[0] += bflo(q.x) * w0.x; a8[1] += bfhi(q.x) * w0.y; a8[2] += bflo(q.y) * w0.z; a8[3] += bfhi(q.y) * w0.w;
                        a8[4] += bflo(q.z) * w1.x; a8[5] += bfhi(q.z) * w1.y; a8[6] += bflo(q.w) * w1.z; a8[7] += bfhi(q.w) * w1.w;
                        if (tap == 3) {
                            float* dst = nullptr; const int col = t * 512 + h * 128 + l16 * 8;
                            if (!samp) { if (nq == 127 && i >= 61) dst = P.out + O_PC + (size_t)((l * 2 + bq) * 3 + (i - 61)) * 1536 + col; }
                            else if (i >= 13) dst = P.out + O_SC + (size_t)((l * 16 + sb) * 3 + (i - 13)) * 1536 + col;
                            if (dst) { *(f32x4*)dst = (f32x4){bflo(q.x), bfhi(q.x), bflo(q.y), bfhi(q.y)}; *(f32x4*)(dst + 4) = (f32x4){bflo(q.z), bfhi(q.z), bflo(q.w), bfhi(q.w)}; }
                        }
                    }
#pragma unroll
                    for (int e = 0; e < 8; ++e) a8[e] = silu_f(a8[e]);
                }
                if (t < 2) {
                    float ss = 0.f;
#pragma unroll
                    for (int e = 0; e < 8; ++e) ss += a8[e] * a8[e];
                    ss = red16(ss);
                    float sc = rsqrtf(ss + EPS); if (t == 0) sc *= 0.08838834764831845f;
                    u32x4 w; w.x = pk2(a8[0] * sc, a8[1] * sc); w.y = pk2(a8[2] * sc, a8[3] * sc); w.z = pk2(a8[4] * sc, a8[5] * sc); w.w = pk2(a8[6] * sc, a8[7] * sc);
                    *(LAS u32x4*)((t == 0 ? sQ : sK) + i * 136 + l16 * 8) = w;
                } else {
                    *(LAS f32x4*)(sV + i * 128 + l16 * 8) = (f32x4){a8[0], a8[1], a8[2], a8[3]};
                    *(LAS f32x4*)(sV + i * 128 + l16 * 8 + 4) = (f32x4){a8[4], a8[5], a8[6], a8[7]};
                }
            }
        }
    }
    __syncthreads();
    {
        const int n = lane & 15, g = lane >> 4, mi = wave >> 1, nb = (wave & 1) * 2;
        f32x4 akk[2], aqk[2];
#pragma unroll
        for (int t = 0; t < 2; ++t) { akk[t] = (f32x4){0.f, 0.f, 0.f, 0.f}; aqk[t] = (f32x4){0.f, 0.f, 0.f, 0.f}; }
#pragma unroll
        for (int kk = 0; kk < 4; ++kk) {
            const bf16x8 ak = *(const LAS bf16x8*)(sK + (mi * 16 + n) * 136 + kk * 32 + g * 8);
            const bf16x8 aq = *(const LAS bf16x8*)(sQ + (mi * 16 + n) * 136 + kk * 32 + g * 8);
#pragma unroll
            for (int t = 0; t < 2; ++t) {
                const bf16x8 bk = *(const LAS bf16x8*)(sK + ((nb + t) * 16 + n) * 136 + kk * 32 + g * 8);
                akk[t] = MFMA16(ak, bk, akk[t]); aqk[t] = MFMA16(aq, bk, aqk[t]);
            }
        }
#pragma unroll
        for (int t = 0; t < 2; ++t) {
            const int j = (nb + t) * 16 + n; const float gcj = sGc[j];
#pragma unroll
            for (int r = 0; r < 4; ++r) {
                const int i = mi * 16 + g * 4 + r;
                const float dec = (i >= j) ? __expf(sGc[i] - gcj) : 0.f;
                sAT[j * 64 + i] = (i > j) ? sBeta[i] * akk[t][r] * dec : 0.f;
                qkb[i * 64 + j] = f2bf(aqk[t][r] * dec);
            }
        }
    }
    __syncthreads();
    if (tid < 256) {
        int z; asm volatile("v_mov_b32 %0, 0" : "=v"(z));
        const LAS float* sATz = sAT + z; const LAS float* sBz = sBeta + z; const LAS float* sEz = sEg + z;
        float r[64];
        if (tid < 128) {
#pragma unroll
            for (int i = 0; i < 64; ++i) r[i] = sV[i * 128 + tid] * sBz[i];
        } else {
#pragma unroll
            for (int i = 0; i < 64; ++i) r[i] = bf2f(sK[i * 136 + tid - 128]) * sBz[i] * sEz[i];
        }
#pragma unroll
        for (int j = 0; j < 63; ++j) {
            const float rj = r[j];
            f32x4 a4[16];
#pragma unroll
            for (int q = (j + 1) / 4; q < 16; ++q) a4[q] = *(const LAS f32x4*)(sATz + j * 64 + q * 4);
#pragma unroll
            for (int i = j + 1; i < 64; ++i) r[i] -= a4[i >> 2][i & 3] * rj;
            __builtin_amdgcn_sched_barrier(0);
        }
        if (tid < 128) {
            bf16_t* uT = d1 + 24576 + tid * 64;
#pragma unroll
            for (int q = 0; q < 8; ++q) { u32x4 w; w.x = pk2(r[q * 8], r[q * 8 + 1]); w.y = pk2(r[q * 8 + 2], r[q * 8 + 3]); w.z = pk2(r[q * 8 + 4], r[q * 8 + 5]); w.w = pk2(r[q * 8 + 6], r[q * 8 + 7]); *(u32x4*)(uT + q * 8) = w; }
        } else {
            const int d = tid - 128, rem = d & 31;
            bf16_t* wcol = d1 + ((d >> 5) * 32 + ((rem & 15) >> 2) * 8 + (rem >> 4) * 4 + (rem & 3));
#pragma unroll
            for (int i = 0; i < 64; ++i) wcol[i * 128] = f2bf(r[i]);
        }
    } else {
        const int tt = tid - 256;
        {
            const int i = tt >> 2, d0 = (tt & 3) * 32; const float eg = sEg[i];
#pragma unroll
            for (int q = 0; q < 4; ++q) {
                const u32x4 v = *(const LAS u32x4*)(sQ + i * 136 + d0 + q * 8);
                u32x4 w; w.x = pk2(bflo(v.x) * eg, bfhi(v.x) * eg); w.y = pk2(bflo(v.y) * eg, bfhi(v.y) * eg); w.z = pk2(bflo(v.z) * eg, bfhi(v.z) * eg); w.w = pk2(bflo(v.w) * eg, bfhi(v.w) * eg);
                *(u32x4*)(d1 + 16384 + i * 128 + d0 + q * 8) = w;
            }
        }
        {
            const int d = tt >> 1, j0 = (tt & 1) * 32; const float gl = sGl[0];
#pragma unroll
            for (int q = 0; q < 4; ++q) {
                float v[8];
#pragma unroll
                for (int e = 0; e < 8; ++e) { const int j = j0 + 4 * q + (e & 3) + 16 * (e >> 2); v[e] = bf2f(sK[j * 136 + d]) * __expf(gl - sGc[j]); }
                u32x4 w; w.x = pk2(v[0], v[1]); w.y = pk2(v[2], v[3]); w.z = pk2(v[4], v[5]); w.w = pk2(v[6], v[7]);
                *(u32x4*)(d1 + 8192 + d * 64 + j0 + q * 8) = w;
            }
        }
    }
    __syncthreads();
}

__device__ __forceinline__ void pool_task(const Params& P, int l, int ptask, LAS unsigned char* lds, int tid0, int bid0) {
    int tidl = tid0; asm volatile("" : "+v"(tidl));
    const int tid = tidl, lane = tid & 63, wave = tid >> 6;
    const int c = ptask >> 2, gi = ptask & 3, win = 2 << gi;
    const bool samp = c >= 256; const int sb = c - 256;
    const int row0 = samp ? MP + sb * 16 : c * 64, nvalid = samp ? 16 : 64;
    const int bq = c >> 7, nq = c & 127;
    LAS float* sU = (LAS float*)lds;
    LAS bf16_t* sD = (LAS bf16_t*)(lds + 50560);
    const bf16_t* p = (const bf16_t*)(P.ws + WS_AREG);
    bf16_t* mix = (bf16_t*)(P.ws + WS_MIX);
    {
        u32x4 st[3]; f32x4 sf0[3], sf1[3];
#pragma unroll
        for (int q = 0; q < 3; ++q) {
            const int idx = q * 512 + tid; st[q] = (u32x4){0u, 0u, 0u, 0u}; sf0[q] = (f32x4){0.f, 0.f, 0.f, 0.f}; sf1[q] = sf0[q];
            if (idx < 79 * 16) {
                const int rrow = idx >> 4, pc = idx & 15, rel = rrow - 15, ch = gi * 128 + pc * 8;
                if (!samp) { const int pos = nq * 64 + rel; if (pos >= 0) st[q] = *(const u32x4*)(p + (size_t)(bq * SEQ + pos) * PW + 2048 + ch); }
                else if (rel < 0) { const float* sp = P.in[4] + (size_t)((l * 16 + sb) * 15 + 15 + rel) * 512 + ch; sf0[q] = *(const f32x4*)sp; sf1[q] = *(const f32x4*)(sp + 4); }
                else if (rel < 16) st[q] = *(const u32x4*)(p + (size_t)(row0 + rel) * PW + 2048 + ch);
            }
        }
#pragma unroll
        for (int q = 0; q < 3; ++q) {
            const int idx = q * 512 + tid;
            if (idx < 79 * 16) {
                const int rrow = idx >> 4, pc = idx & 15;
                f32x4 v0, v1;
                if (samp && rrow < 15) { v0 = sf0[q]; v1 = sf1[q]; }
                else { v0 = (f32x4){bflo(st[q].x), bfhi(st[q].x), bflo(st[q].y), bfhi(st[q].y)}; v1 = (f32x4){bflo(st[q].z), bfhi(st[q].z), bflo(st[q].w), bfhi(st[q].w)}; }
                *(LAS f32x4*)(sU + rrow * 160 + pc * 8) = v0; *(LAS f32x4*)(sU + rrow * 160 + pc * 8 + 4) = v1;
            }
        }
    }
    __syncthreads();
    {
        const int i = tid >> 3, l8 = tid & 7;
        const int have_n = samp ? win : min(win, nq * 64 + i + 1);
        const float inv = 1.f / (float)have_n;
#pragma unroll
        for (int q = 0; q < 4; ++q) {
            const int ch = q * 32 + l8 * 4;
            f32x4 sum = (f32x4){0.f, 0.f, 0.f, 0.f};
            const f32x4 cur = *(const LAS f32x4*)(sU + (15 + i) * 160 + ch);
            for (int t = 0; t < win; ++t) sum += *(const LAS f32x4*)(sU + (15 + i - t) * 160 + ch);
            const f32x4 d = (i < nvalid) ? sum * inv - cur : (f32x4){0.f, 0.f, 0.f, 0.f};
            u32x2 w; w.x = pk2(d.x, d.y); w.y = pk2(d.z, d.w);
            *(LAS u32x2*)(sD + i * 136 + ch) = w;
            float* dst = nullptr;
            if (!samp) { if (nq == 127 && i >= 49) dst = P.out + O_PP + (size_t)((l * 2 + bq) * 15 + (i - 49)) * 512 + gi * 128 + ch; }
            else if (i >= 1 && i < 16) dst = P.out + O_SP + (size_t)((l * 16 + sb) * 15 + (i - 1)) * 512 + gi * 128 + ch;
            if (dst) *(f32x4*)dst = cur;
        }
    }
    __syncthreads();
    {
        const int n = lane & 15, g = lane >> 4, ni = wave;
        const bf16_t* wpt = (const bf16_t*)(P.ws + WS_WPT) + (size_t)(l * 4 + gi) * 16384;
        f32x4 acc[4];
#pragma unroll
        for (int mi = 0; mi < 4; ++mi) acc[mi] = (f32x4){0.f, 0.f, 0.f, 0.f};
#pragma unroll
        for (int kk = 0; kk < 4; ++kk) {
            const bf16x8 b = *(const bf16x8*)(wpt + (ni * 16 + n) * 128 + kk * 32 + g * 8);
#pragma unroll
            for (int mi = 0; mi < 4; ++mi) { const bf16x8 a = *(const LAS bf16x8*)(sD + (mi * 16 + n) * 136 + kk * 32 + g * 8); acc[mi] = MFMA16(a, b, acc[mi]); }
        }
        const int dcol = gi * 128 + ni * 16 + n; const float sc = P.in[16][l * 512 + dcol];
#pragma unroll
        for (int mi = 0; mi < 4; ++mi)
#pragma unroll
            for (int r = 0; r < 4; ++r) { const int i = mi * 16 + g * 4 + r; if (i < nvalid) mix[(size_t)(row0 + i) * D + 512 + dcol] = f2bf(acc[mi][r] * sc); }
    }
    __syncthreads();
}

__device__ __forceinline__ void d2h_dma(const bf16_t* d1, int c0, LAS unsigned char* buf, int hw, int lane) {
#pragma unroll
    for (int q = 0; q < 10; ++q) {
        const int sl = q * 256 + hw * 64 + lane;
        const bf16_t* src;
        if (q < 4) { const int r = sl >> 4, c = (sl & 15) ^ (r & 15); src = d1 + r * 128 + c * 8; }
        else if (q < 8) { const int s2 = sl - 1024, r = s2 >> 3, c = (s2 & 7) ^ (r & 7); src = d1 + 8192 + r * 64 + c * 8; }
        else { const int s2 = sl - 2048, r = s2 >> 3, c = (s2 & 7) ^ (r & 7); src = d1 + 24576 + (c0 + r) * 64 + c * 8; }
        __builtin_amdgcn_global_load_lds((const unsigned*)src, (LAS unsigned*)(buf + (q * 256 + hw * 64) * 16), 16, 0, 0);
    }
}
__device__ __forceinline__ void d2c_drain(const Params& P, LAS unsigned char* sb, int task, int col0, int lane) {
    bf16_t* d1 = (bf16_t*)(P.ws + WS_D1) + (size_t)task * 32768;
    bf16_t* snt = (bf16_t*)((unsigned char*)P.out + DO_SNT) + (size_t)task * 16384;
    u32x4 v[6];
#pragma unroll
    for (int q = 0; q < 4; ++q) { const int L = q * 64 + lane, row = L >> 4, c = L & 15; v[q] = *(const LAS u32x4*)(sb + row * 256 + ((c ^ row) * 16)); }
#pragma unroll
    for (int q = 0; q < 2; ++q) { const int L = q * 64 + lane, row = L >> 3, c = L & 7; v[4 + q] = *(const LAS u32x4*)(sb + 4096 + row * 128 + ((c ^ (row & 7)) * 16)); }
#pragma unroll
    for (int q = 0; q < 4; ++q) *(u32x4*)(snt + col0 * 128 + (q * 64 + lane) * 8) = v[q];
#pragma unroll
    for (int q = 0; q < 2; ++q) *(u32x4*)(d1 + 24576 + col0 * 64 + (q * 64 + lane) * 8) = v[4 + q];
}
__device__ __forceinline__ void d2c_step(LAS unsigned char* buf, LAS unsigned char* stg, float egc, int e0l, int n, int g, f32x4 (&S)[8]) {
    u32x2 uu[4]; bf16x8 Af[4][4];
#pragma unroll
    for (int mt = 0; mt < 4; ++mt) { const int r = e0l + n, c = mt * 2 + (g >> 1); uu[mt] = *(const LAS u32x2*)(buf + 32768 + (r * 8 + (c ^ (r & 7))) * 16 + (g & 1) * 8); }
#pragma unroll
    for (int s = 0; s < 4; ++s)
#pragma unroll
        for (int mt = 0; mt < 4; ++mt) { const int r = mt * 16 + n; Af[s][mt] = *(const LAS bf16x8*)(buf + (r * 16 + ((s * 4 + g) ^ (r & 15))) * 16); }
    u32x2 Pk[8];
#pragma unroll
    for (int mt = 0; mt < 8; ++mt) { Pk[mt].x = pk2(S[mt][0], S[mt][1]); Pk[mt].y = pk2(S[mt][2], S[mt][3]); }
#pragma unroll
    for (int mt = 0; mt < 8; ++mt) *(LAS u32x2*)(stg + n * 256 + (((mt * 2 + (g >> 1)) ^ n) * 16) + (g & 1) * 8) = Pk[mt];
    __builtin_amdgcn_sched_barrier(0);
    f32x4 vt[4];
#pragma unroll
    for (int mt = 0; mt < 4; ++mt) vt[mt] = (f32x4){-bflo(uu[mt].x), -bfhi(uu[mt].x), -bflo(uu[mt].y), -bfhi(uu[mt].y)};
#pragma unroll
    for (int s = 0; s < 4; ++s) {
        u32x4 bv; bv.x = Pk[2 * s].x; bv.y = Pk[2 * s].y; bv.z = Pk[2 * s + 1].x; bv.w = Pk[2 * s + 1].y;
        const bf16x8 bf = __builtin_bit_cast(bf16x8, bv);
#pragma unroll
        for (int mt = 0; mt < 4; ++mt) vt[mt] = MFMA16(Af[s][mt], bf, vt[mt]);
    }
    __builtin_amdgcn_sched_barrier(0);
    bf16x8 Kf[8][2];
#pragma unroll
    for (int mt = 0; mt < 8; ++mt)
#pragma unroll
        for (int s = 0; s < 2; ++s) { const int r = mt * 16 + n; Kf[mt][s] = *(const LAS bf16x8*)(buf + 16384 + (r * 8 + ((s * 4 + g) ^ (r & 7))) * 16); }
#pragma unroll
    for (int mt = 0; mt < 8; ++mt) S[mt] = S[mt] * egc;
    __builtin_amdgcn_sched_barrier(0);
    u32x2 Vp[4];
#pragma unroll
    for (int mt = 0; mt < 4; ++mt) {
        Vp[mt].x = pk2(-vt[mt][0], -vt[mt][1]); Vp[mt].y = pk2(-vt[mt][2], -vt[mt][3]);
        *(LAS u32x2*)(stg + 4096 + n * 128 + (((mt * 2 + (g >> 1)) ^ (n & 7)) * 16) + (g & 1) * 8) = Vp[mt];
    }
    bf16x8 vb[2];
#pragma unroll
    for (int s = 0; s < 2; ++s) { u32x4 bv; bv.x = Vp[2 * s].x; bv.y = Vp[2 * s].y; bv.z = Vp[2 * s + 1].x; bv.w = Vp[2 * s + 1].y; vb[s] = __builtin_bit_cast(bf16x8, bv); }
#pragma unroll
    for (int s = 0; s < 2; ++s)
#pragma unroll
        for (int mt = 0; mt < 8; ++mt) S[mt] = MFMA16(Kf[mt][s], vb[s], S[mt]);
}
#define D2_BAR() do { asm volatile("s_waitcnt lgkmcnt(0)" ::: "memory"); __builtin_amdgcn_s_barrier(); asm volatile("" ::: "memory"); } while (0)
__device__ __forceinline__ void d2_seq(const Params& P, LAS unsigned char* lds, int chunk0, int nch, int h, int c0, const float* s0, float* sout, int tid0, int bid0) {
    const int tid = tid0, lane = tid & 63, wave = tid >> 6, n = lane & 15, g = lane >> 4;
    const bool comp = wave < 4;
    const int e0l = (wave & 3) * 16, hw = __builtin_amdgcn_readfirstlane(wave & 3);
    const int task0 = chunk0 * 4 + h;
    const bf16_t* d1base = (const bf16_t*)(P.ws + WS_D1) + (size_t)task0 * 32768;
    constexpr size_t TS = 4 * 32768;
    LAS unsigned char* stgw = lds + 122880 + (wave & 3) * 6144;
    LAS float* sEG = (LAS float*)(lds + 147456);
    f32x4 S[8];
    const int last = nch - 1;
    if (comp) {
#pragma unroll
        for (int mt = 0; mt < 8; ++mt)
#pragma unroll
            for (int r = 0; r < 4; ++r) S[mt][r] = s0 ? s0[(mt * 16 + g * 4 + r) * 128 + c0 + e0l + n] : 0.f;
    } else {
        d2h_dma(d1base, c0, lds, hw, lane);
        d2h_dma(d1base + (size_t)min(1, last) * TS, c0, lds + 40960, hw, lane);
        asm volatile("s_waitcnt vmcnt(10)" ::: "memory");
    }
    if (tid < nch) sEG[tid] = ((const float*)(P.ws + WS_GL))[task0 + 4 * tid];
    D2_BAR();
    int rb = 0;
#pragma unroll 1
    for (int ci = 0; ci < nch; ++ci) {
        LAS unsigned char* cur = lds + rb * 40960;
        const int rb2 = rb >= 1 ? rb - 1 : 2;
        if (comp) {
            d2c_step(cur, stgw, sEG[ci], e0l, n, g, S);
            asm volatile("s_waitcnt lgkmcnt(0)" ::: "memory");
            d2c_drain(P, stgw, task0 + ci * 4, c0 + e0l, lane);
        } else {
            int ll = lane; asm volatile("" : "+v"(ll));
            d2h_dma(d1base + (size_t)min(ci + 2, last) * TS, c0, lds + rb2 * 40960, hw, ll);
            asm volatile("s_waitcnt vmcnt(10)" ::: "memory");
        }
        D2_BAR();
        rb = rb == 2 ? 0 : rb + 1;
    }
    if (comp) {
#pragma unroll
        for (int mt = 0; mt < 8; ++mt)
#pragma unroll
            for (int r = 0; r < 4; ++r) sout[(mt * 16 + g * 4 + r) * 128 + c0 + e0l + n] = S[mt][r];
    } else {
        asm volatile("s_waitcnt vmcnt(0)" ::: "memory");
    }
    D2_BAR();
}

__device__ __forceinline__ void d3_task(const Params& P, int l, int task, LAS unsigned char* lds, int tid0, int bid0) {
    int tidl = tid0; asm volatile("" : "+v"(tidl));
    const int tid = tidl, lane = tid & 63, wave = tid >> 6;
    const int c = task >> 2, h = task & 3;
    const bool samp = c >= 256; const int sb = c - 256;
    const int row0 = samp ? MP + sb * 16 : c * 64, nvalid = samp ? 16 : 64;
    const int n = lane & 15, g = lane >> 4, e0 = wave * 16;
    LAS bf16_t* sGate = (LAS bf16_t*)(lds + 73728); LAS bf16_t* sOut = (LAS bf16_t*)(lds + 90112); LAS float* sSS = (LAS float*)(lds + 106496);
    const bf16_t* d1 = (const bf16_t*)(P.ws + WS_D1) + (size_t)task * 32768;
    const bf16_t* snt = (const bf16_t*)((unsigned char*)P.out + DO_SNT) + (size_t)task * 16384;
    const bf16_t* qkb = (const bf16_t*)((unsigned char*)P.out + DO_QK) + (size_t)task * 4096;
    const bf16_t* p = (const bf16_t*)(P.ws + WS_AREG);
    bf16_t* mix = (bf16_t*)(P.ws + WS_MIX);
    {
        u32x4 st[11];
#pragma unroll
        for (int q = 0; q < 11; ++q) {
            const int idx = q * 512 + tid;
            const bf16_t* src;
            if (q < 2) src = d1 + 16384 + idx * 8;
            else if (q < 6) src = snt + (idx - 1024) * 8;
            else if (q < 7) src = qkb + (idx - 3072) * 8;
            else if (q < 9) src = d1 + 24576 + (idx - 3584) * 8;
            else { const int i5 = idx - 4608, r = min(i5 >> 4, nvalid - 1); src = p + (size_t)(row0 + r) * PW + 1536 + h * 128 + (i5 & 15) * 8; }
            st[q] = __builtin_nontemporal_load((const u32x4*)src);
        }
#pragma unroll
        for (int q = 0; q < 11; ++q) {
            const int idx = q * 512 + tid;
            int off;
            if (q < 2) { const int r = idx >> 4, cc = idx & 15; off = (r * 16 + (cc ^ (r & 15))) * 16; }
            else if (q < 6) { const int i2 = idx - 1024, r = i2 >> 4, cc = i2 & 15; off = 16384 + (r * 16 + (cc ^ (r & 15))) * 16; }
            else if (q < 7) { const int i3 = idx - 3072, r = i3 >> 3, cc = i3 & 7; off = 49152 + (r * 8 + (cc ^ (r & 7))) * 16; }
            else if (q < 9) { const int i4 = idx - 3584, r = i4 >> 3, cc = i4 & 7; off = 57344 + (r * 8 + (cc ^ (r & 7))) * 16; }
            else off = 73728 + (idx - 4608) * 16;
            *(LAS u32x4*)(lds + off) = st[q];
        }
    }
    __syncthreads();
    f32x4 acc[4];
#pragma unroll
    for (int mt = 0; mt < 4; ++mt) acc[mt] = (f32x4){0.f, 0.f, 0.f, 0.f};
#pragma unroll
    for (int kk = 0; kk < 4; ++kk) {
        const int rb = e0 + n;
        const bf16x8 b = *(const LAS bf16x8*)(lds + 16384 + (rb * 16 + ((kk * 4 + g) ^ (rb & 15))) * 16);
#pragma unroll
        for (int mt = 0; mt < 4; ++mt) { const int r = mt * 16 + n; const bf16x8 a = *(const LAS bf16x8*)(lds + (r * 16 + ((kk * 4 + g) ^ (r & 15))) * 16); acc[mt] = MFMA16(a, b, acc[mt]); }
    }
#pragma unroll
    for (int kk = 0; kk < 2; ++kk) {
        const int rb = e0 + n;
        const bf16x8 b = *(const LAS bf16x8*)(lds + 57344 + (rb * 8 + ((kk * 4 + g) ^ (rb & 7))) * 16);
#pragma unroll
        for (int mt = 0; mt < 4; ++mt) { const int r = mt * 16 + n; const bf16x8 a = *(const LAS bf16x8*)(lds + 49152 + (r * 8 + ((kk * 4 + g) ^ (r & 7))) * 16); acc[mt] = MFMA16(a, b, acc[mt]); }
    }
#pragma unroll
    for (int mt = 0; mt < 4; ++mt)
#pragma unroll
        for (int r = 0; r < 4; ++r) {
            float ss = acc[mt][r] * acc[mt][r];
            ss = red16(ss);
            if (n == 0) sSS[wave * 64 + mt * 16 + g * 4 + r] = ss;
        }
    __syncthreads();
    const float onw = P.in[14][l * 128 + e0 + n];
#pragma unroll
    for (int mt = 0; mt < 4; ++mt)
#pragma unroll
        for (int r = 0; r < 4; ++r) {
            const int i = mt * 16 + g * 4 + r;
            float tot = 0.f;
#pragma unroll
            for (int w = 0; w < 8; ++w) tot += sSS[w * 64 + i];
            const float rstd = rsqrtf(tot * (1.f / 128.f) + EPS);
            const float gt = bf2f(sGate[i * 128 + e0 + n]);
            sOut[i * 128 + e0 + n] = f2bf(acc[mt][r] * rstd * onw * silu_f(gt));
        }
    __syncthreads();
#pragma unroll
    for (int q = 0; q < 2; ++q) {
        const int idx = q * 512 + tid, i = idx >> 4, cc = idx & 15;
        if (i < nvalid) *(u32x4*)(mix + (size_t)(row0 + i) * D + h * 128 + cc * 8) = *(const LAS u32x4*)(sOut + i * 128 + cc * 8);
    }
    __syncthreads();
}

__global__ void __launch_bounds__(512, 2) fwd_kernel(Params P) {
    extern __shared__ __attribute__((aligned(16))) unsigned char lds_raw[];
    LAS unsigned char* lds = (LAS unsigned char*)lds_raw;
    cg::grid_group grid = cg::this_grid();
    const int G = gridDim.x;
    volatile LAS unsigned* barw = (volatile LAS unsigned*)(lds + LDS_BARW);
    if (threadIdx.x < 4) barw[threadIdx.x] = 0u;
    __syncthreads();
    XcdBarrier xbar; xbar.bar = (unsigned*)(P.ws + WS_BAR); xbar.x = 0; xbar.st = barw;
    const bool multi = P.ph_hi - P.ph_lo > 1;
    if (multi) xbar = xcd_barrier_post((unsigned*)(P.ws + WS_BAR), barw);
    if (P.ph_hi > 1000) grid.sync();
    float* rowss = (float*)(P.ws + WS_ROWSS);
    float* rstdarr = (float*)(P.ws + WS_RSTD);
    bf16_t* xb = (bf16_t*)(P.ws + WS_XB);
    bf16_t* areg = (bf16_t*)(P.ws + WS_AREG);
    bf16_t* wx = (bf16_t*)(P.ws + WS_WX);
    bf16_t* wy = (bf16_t*)((unsigned char*)P.out + DO_WY);
#pragma unroll 1
    for (int ph = P.ph_lo; ph < P.ph_hi; ++ph) {
        int nrep = 1;
#if PROBE_REP
        if (ph > 0 && ph < NPH - 1) { const int k0 = (ph - 1) % 9; if ((PROBE_REP >> k0) & 1) nrep = (k0 == 4) ? 3 : 2; }
#endif
#pragma unroll 1
        for (int rep = 0; rep < nrep; ++rep) {
        int tid = threadIdx.x; asm volatile("" : "+v"(tid));
        int bid = blockIdx.x; asm volatile("" : "+s"(bid));
        const int lane = tid & 63, wave = tid >> 6;
        if ((PHM & 1) && ph == 0) {
            phase0(P, lds, tid, bid);
        } else if ((PHM & 2) && ph == NPH - 1) {
            const float* nf = P.in[22]; const float* rs = rstdarr + (size_t)6 * M;
            f32x4 w0[2], w1[2];
#pragma unroll
            for (int j = 0; j < 2; ++j) { const int cc = (lane + 64 * j) * 8; w0[j] = *(const f32x4*)(nf + cc); w1[j] = *(const f32x4*)(nf + cc + 4); }
            for (int r0 = bid * 8 + wave; r0 < M; r0 += 4 * G * 8) {
                u32x4 xv[4][2]; float rstd[4];
#pragma unroll
                for (int u = 0; u < 4; ++u) {
                    const int r = min(r0 + u * G * 8, M - 1);
                    rstd[u] = rs[r];
#pragma unroll
                    for (int j = 0; j < 2; ++j) xv[u][j] = *(const u32x4*)(xb + (size_t)r * D + (lane + 64 * j) * 8);
                }
#pragma unroll
                for (int u = 0; u < 4; ++u) {
                    const int r = r0 + u * G * 8;
                    if (r < M) {
#pragma unroll
                        for (int j = 0; j < 2; ++j) {
                            const int cc = (lane + 64 * j) * 8; const u32x4 q = xv[u][j];
                            *(f32x4*)(P.out + (size_t)r * D + cc) = (f32x4){bflo(q.x), bfhi(q.x), bflo(q.y), bfhi(q.y)} * rstd[u] * w0[j];
                            *(f32x4*)(P.out + (size_t)r * D + cc + 4) = (f32x4){bflo(q.z), bfhi(q.z), bflo(q.w), bfhi(q.w)} * rstd[u] * w1[j];
                        }
                    }
                }
            }
        } else {
            const int l = (ph - 1) / 9, k = (nrep == 3 && rep == 1) ? 3 : (ph - 1) % 9;
            if ((PHM & 4) && (k == 0 || k == 7)) {
                pg8::Gemm g{xb, k == 0 ? wx + WX_UP / 2 : wy + WY_UP / 2, M, NUP, D, D};
                pg8::StaticOrder S; S.init(M, NUP, G, bid);
                EpiUp E{areg, rstdarr + (size_t)(3 * l + (k == 0 ? 0 : 2)) * M};
                pg8::gemm_phase<EpiUp, pg8::StaticOrder, true, true>(lds, g, S, E, tid);
            } else if ((PHM & 8) && (k == 1 || k == 6 || k == 8)) {
                const bf16_t* A = k == 6 ? (const bf16_t*)(P.ws + WS_MIX) : areg;
                const bf16_t* Bt = k == 1 ? wx + WX_DOWN / 2 : (k == 6 ? wy + WY_OUT / 2 : wy + WY_DOWN / 2);
                const int K = k == 6 ? D : FF;
                const int so = 3 * l + (k == 1 ? 1 : (k == 6 ? 2 : 3));
                const float scale = k == 6 ? 1.f : 0.5f; const int f32out = 0;
                float* part = (float*)(P.ws + (k == 6 ? WS_AREG : WS_MIX));
                {
                    pg8::Gemm g{A, Bt, MP, D, K, K};
                    pg8::StaticOrder S; S.init(MP, D, G, bid);
                    EpiRes E{xb, (float*)(P.ws + WS_D1), rowss + (size_t)so * M * 16, scale, f32out};
                    pg8::gemm_phase<EpiRes, pg8::StaticOrder, false, true>(lds, g, S, E, tid);
                }
                {
                    const int nsl = K >> 8, s = bid >> 2;
                    pg8::Gemm g{A + (size_t)MP * K + s * 256, Bt + s * 256, 256, D, 256, K};
                    SingleOrder S{bid & 3, bid < 4 * nsl};
                    EpiPart E{part + (size_t)s * 256 * D};
                    pg8::gemm_phase<EpiPart, SingleOrder, false, true>(lds, g, S, E, tid);
                    xcd_barrier(xbar);
                    const int r = bid * 8 + wave;
                    if (r < 256) {
                        bf16_t* xr = xb + (size_t)(MP + r) * D; float ss = 0.f;
#pragma unroll
                        for (int j = 0; j < 4; ++j) {
                            const int cc = (lane + 64 * j) * 4;
                            const u32x2 xv = *(const u32x2*)(xr + cc);
                            f32x4 pv[11];
#pragma unroll
                            for (int q = 0; q < 11; ++q) pv[q] = q < nsl ? *(const f32x4*)(part + ((size_t)q * 256 + r) * D + cc) : (f32x4){0.f, 0.f, 0.f, 0.f};
                            f32x4 a = pv[0];
#pragma unroll
                            for (int q = 1; q < 11; ++q) a += pv[q];
                            const f32x4 v = (f32x4){bflo(xv.x), bfhi(xv.x), bflo(xv.y), bfhi(xv.y)} + a * scale;
                            ss += (v.x * v.x + v.y * v.y) + (v.z * v.z + v.w * v.w);
                            if (f32out) *(f32x4*)((float*)(P.ws + WS_D1) + (size_t)(MP + r) * D + cc) = v;
                            else { u32x2 w; w.x = pk2(v.x, v.y); w.y = pk2(v.z, v.w); *(u32x2*)(xr + cc) = w; }
                        }
                        ss = wave_sum(ss);
                        if (lane == 0) rstdarr[(size_t)so * M + MP + r] = rsqrtf(ss * (1.f / 1024.f) + 1e-6f);
                    }
                    {
                        const float* ps = rowss + (size_t)so * M * 16; float* rd = rstdarr + (size_t)so * M;
                        const int gw = bid * 8 + wave, nw = G * 8;
                        for (int r0 = gw * 4; r0 < MP; r0 += nw * 16) {
                            float v[4];
#pragma unroll
                            for (int q = 0; q < 4; ++q) { const int rb = r0 + q * nw * 4; v[q] = rb < MP ? ps[(size_t)rb * 16 + lane] : 0.f; }
#pragma unroll
                            for (int q = 0; q < 4; ++q) {
                                float t = v[q];
                                t += __shfl_xor(t, 1); t += __shfl_xor(t, 2); t += __shfl_xor(t, 4); t += __shfl_xor(t, 8);
                                const int rb = r0 + q * nw * 4;
                                if ((lane & 15) == 0 && rb < MP) rd[rb + (lane >> 4)] = rsqrtf(t * (1.f / 1024.f) + 1e-6f);
                            }
                        }
                    }
                }
            } else if ((PHM & 16) && k == 2) {
                pg8::Gemm g{xb, wx + WX_WIN / 2, M, NINP, D, D};
                pg8::StaticOrder S; S.init(M, NINP, G, bid);
                EpiIn E{areg, (float*)(P.ws + WS_AB), rstdarr + (size_t)(3 * l + 1) * M};
                pg8::gemm_phase<EpiIn, pg8::StaticOrder, true, true>(lds, g, S, E, tid);
            } else if ((PHM & 32) && k == 3) {
                for (int t = bid; t < NTASK; t += G) d1_task(P, l, t, lds, tid, bid);
            } else if ((PHM & 64) && k == 4) {
                if (bid < 144) {
                    int chunk0, nch, h, half; const float* s0 = nullptr; float* sout;
                    if (bid < 16) { const int bh = bid >> 1, b = bh >> 2; half = bid & 1; h = bh & 3; chunk0 = b * 128; nch = 128; sout = P.out + O_PD + (size_t)((l * 2 + b) * 4 + h) * 16384; }
                    else { const int j = (bid - 16) >> 1, sb = j >> 2; half = (bid - 16) & 1; h = j & 3; chunk0 = 256 + sb; nch = 1;
                        s0 = P.in[2] + (size_t)((l * 16 + sb) * 4 + h) * 16384; sout = P.out + O_SD + (size_t)((l * 16 + sb) * 4 + h) * 16384; }
                    d2_seq(P, lds, chunk0, nch, h, half * 64, s0, sout, tid, bid);
                } else {
                    convert_weights(P, l == 0 ? 0 : 1, 1, (bid - 144) * 8 + wave, (G - 144) * 8, (LAS float*)(lds + wave * 16384), lane);
                }
                if (bid >= 16) {
                    __syncthreads();
                    for (int t = bid - 16; t < NPTASK; t += G - 16) pool_task(P, l, t, lds, tid, bid);
                }
            } else if (PHM & 128) {
                for (int t = bid; t < NTASK; t += G) d3_task(P, l, t, lds, tid, bid);
            }
        }
        if (rep + 1 < nrep) xcd_barrier(xbar);
        }
#if PROBE_SYNCS
        if (ph == 0) for (int i = 0; i < PROBE_SYNCS; ++i) xcd_barrier(xbar);
#endif
        if (ph + 1 < P.ph_hi) xcd_barrier(xbar);
    }
}

#ifndef ONE_LAUNCH
#define ONE_LAUNCH 1
#endif
extern "C" void kernel_launch(void* const* d_in, const int* in_sizes, int n_in, void* d_out, int out_size, void* d_ws, size_t ws_size, hipStream_t stream) {
    static int grid = 0;
    if (grid == 0) {
        int dev = 0, cus = 0, per_cu = 0;
        hipGetDevice(&dev);
        hipDeviceGetAttribute(&cus, hipDeviceAttributeMultiprocessorCount, dev);
        hipFuncSetAttribute((const void*)fwd_kernel, hipFuncAttributeMaxDynamicSharedMemorySize, LDS_BYTES);
        hipOccupancyMaxActiveBlocksPerMultiprocessor(&per_cu, (const void*)fwd_kernel, 512, LDS_BYTES);
        (void)hipGetLastError();
        if (per_cu < 1) per_cu = 1;
        grid = cus;
        if (grid < 160) grid = 160;
    }
    Params p{};
    for (int i = 0; i < 23; ++i) p.in[i] = (const float*)d_in[i];
    p.out = (float*)d_out; p.ws = (unsigned char*)d_ws;
#if ONE_LAUNCH
    (void)hipMemsetAsync((unsigned char*)d_ws + WS_BAR, 0, XCD_BAR_WORDS * 4, stream);
    p.ph_lo = 0; p.ph_hi = NPH;
    void* args[] = {&p};
    hipLaunchCooperativeKernel((const void*)fwd_kernel, dim3(grid), dim3(512), args, LDS_BYTES, stream);
#else
    for (int ph = 0; ph < NPH; ++ph) {
        p.ph_lo = ph; p.ph_hi = ph + 1;
        hipLaunchKernelGGL(fwd_kernel, dim3(grid), dim3(512), LDS_BYTES, stream, p);
    }
#endif
}
```
